# Optimizing an MI355X kernel written in HIP

```python
import math
import jax
import jax.numpy as jnp
from jax import lax
import numpy as np

D_MODEL = 1024
BATCH = 8
SEQ = 8192
DEPTH = 2
DEC_BATCH = 16
DEC_SEQ = 64
PAST_LEN = 4096

CHUNK = 64
PLE_DIM = 256
N_EVEN = (DEPTH + 1) // 2
N_ODD = DEPTH // 2
EPS = 1e-6
F32 = jnp.float32
A_WIDTH = 512
A_GROUPS = 4
A_GROUP_DIM = A_WIDTH // A_GROUPS
MLP_CHUNK = 128
B_WIDTH = 512
B_GROUP_DIM = 16
B_GROUPS = B_WIDTH // B_GROUP_DIM
S5_STATE = 64
SCAN_BLOCK = 128
C_HEADS = 8
C_HEAD_DIM = 64
C_WIDTH = C_HEADS * C_HEAD_DIM
SB_BLOCK = 128
D_HEADS = 4
D_KEY_DIM = 128
D_VAL_DIM = 128
D_WIDTH = D_HEADS * D_VAL_DIM
CONV_W = 4
D_CONV_CH = 2 * D_HEADS * D_KEY_DIM + D_WIDTH
EVEN_IN = 3 * A_WIDTH + 2 * B_WIDTH
EVEN_MIX = A_WIDTH + B_WIDTH
ODD_IN = 4 * C_WIDTH + D_CONV_CH + D_WIDTH + 2 * D_HEADS
ODD_MIX = C_WIDTH + D_WIDTH

kernel_name = 'hybrid_streaming_encoder_step'


def rmsnorm(x, g):
    xf = x.astype(F32)
    var = jnp.mean(xf * xf, axis=-1, keepdims=True)
    return (xf * lax.rsqrt(var + EPS) * g.astype(F32)).astype(x.dtype)


def layernorm(x, g, b):
    xf = x.astype(F32)
    mu = jnp.mean(xf, axis=-1, keepdims=True)
    xc = xf - mu
    var = jnp.mean(xc * xc, axis=-1, keepdims=True)
    return (xc * lax.rsqrt(var + EPS) * g.astype(F32) + b.astype(F32)).astype(x.dtype)


def l2norm(x):
    xf = x.astype(F32)
    return xf * lax.rsqrt(jnp.sum(xf * xf, axis=-1, keepdims=True) + EPS)


def chunk_mlp_mix(u, v, w_s, b_s):
    bsz, L, _ = v.shape
    c = min(L, MLP_CHUNK)
    nc = L // c
    vg = v.reshape(bsz, nc, c, A_GROUPS, A_GROUP_DIM)
    mask = jnp.tril(jnp.ones((c, c), dtype=bool))
    w = jnp.where(mask, w_s[:, :c, :c], 0.0).astype(v.dtype)
    s = jnp.einsum('gts,bnsgd->bntgd', w, vg) + b_s[:, :c].T[None, None, :, :, None].astype(v.dtype)
    return u * s.reshape(bsz, L, A_WIDTH)


def s5_discretize(lam_re, lam_im, log_dt, b_re, b_im):
    dt = jnp.exp(log_dt.astype(F32))[:, None]
    lr, li = lam_re.astype(F32), lam_im.astype(F32)
    mag = jnp.exp(lr * dt)
    ar, ai = mag * jnp.cos(li * dt), mag * jnp.sin(li * dt)
    den = lr * lr + li * li
    cr = ((ar - 1.0) * lr + ai * li) / den
    ci = (ai * lr - (ar - 1.0) * li) / den
    br, bi = b_re.astype(F32), b_im.astype(F32)
    bbr = cr[..., None] * br - ci[..., None] * bi
    bbi = cr[..., None] * bi + ci[..., None] * br
    return ar, ai, bbr, bbi


def complex_affine_combine(e1, e2):
    ar1, ai1, br1, bi1 = e1
    ar2, ai2, br2, bi2 = e2
    return (ar2 * ar1 - ai2 * ai1, ar2 * ai1 + ai2 * ar1,
            ar2 * br1 - ai2 * bi1 + br2, ar2 * bi1 + ai2 * br1 + bi2)


def s5_mix(u, x0_re, x0_im, lam_re, lam_im, log_dt, b_re, b_im, c_re, c_im, d_skip):
    bsz, L, _ = u.shape
    ar, ai, bbr, bbi = s5_discretize(lam_re, lam_im, log_dt, b_re, b_im)
    blk = min(L, SCAN_BLOCK)
    nb = L // blk
    ug = u.astype(F32).reshape(bsz, nb, blk, B_GROUPS, B_GROUP_DIM).swapaxes(0, 1)
    a_re = jnp.broadcast_to(ar, (bsz, blk, B_GROUPS, S5_STATE))
    a_im = jnp.broadcast_to(ai, (bsz, blk, B_GROUPS, S5_STATE))
    cr, ci, dk = c_re.astype(F32), c_im.astype(F32), d_skip.astype(F32)

    def block(carry, ub):
        xr0, xi0 = carry
        bur = jnp.einsum('btgp,gnp->btgn', ub, bbr)
        bui = jnp.einsum('btgp,gnp->btgn', ub, bbi)
        pr, pi, lr_, li_ = lax.associative_scan(complex_affine_combine, (a_re, a_im, bur, bui), axis=1)
        xr = pr * xr0[:, None] - pi * xi0[:, None] + lr_
        xi = pr * xi0[:, None] + pi * xr0[:, None] + li_
        y = jnp.einsum('btgn,gpn->btgp', xr, cr) - jnp.einsum('btgn,gpn->btgp', xi, ci) + dk * ub
        return (xr[:, -1], xi[:, -1]), y

    (xr, xi), y = lax.scan(block, (x0_re.astype(F32), x0_im.astype(F32)), ug)
    y = y.swapaxes(0, 1).reshape(bsz, L, B_WIDTH)
    return y.astype(u.dtype), xr, xi


def stick_breaking_attention(q, k, v, q_offset):
    bsz, L, H, d = q.shape
    S = k.shape[1]
    blk = min(L, SB_BLOCK)
    nb = L // blk
    qb = q.reshape(bsz, nb, blk, H, d).transpose(1, 0, 3, 2, 4)
    kt = k.transpose(0, 2, 1, 3)
    vt = v.transpose(0, 2, 1, 3)
    kpos = jnp.arange(S)
    scale = 1.0 / math.sqrt(d)

    def one_block(args):
        j, qj = args
        qpos = q_offset + j * blk + jnp.arange(blk)
        z = jnp.einsum('bhtd,bhsd->bhts', qj, kt).astype(F32) * scale
        mask = kpos[None, :] < qpos[:, None]
        log_beta = jax.nn.log_sigmoid(z)
        log_keep = jnp.where(mask, log_beta - z, 0.0)
        after = lax.cumsum(log_keep, axis=3, reverse=True) - log_keep
        w = jnp.where(mask, jnp.exp(log_beta + after), 0.0)
        return jnp.einsum('bhts,bhsd->bhtd', w.astype(vt.dtype), vt)

    o = lax.map(one_block, (jnp.arange(nb), qb))
    return o.transpose(1, 0, 3, 2, 4).reshape(bsz, L, H * d)


def causal_conv(x, buf, w):
    L = x.shape[1]
    xp = jnp.concatenate([buf.astype(x.dtype), x], axis=1)
    y = xp[:, 0:L] * w[0]
    for i in range(1, CONV_W):
        y = y + xp[:, i:i + L] * w[i]
    return y, xp[:, -(CONV_W - 1):]


def gdn_chunk(S, q, k, v, g, beta):
    c = q.shape[-2]
    causal = jnp.tril(jnp.ones((c, c), dtype=bool))
    strict = jnp.tril(jnp.ones((c, c), dtype=bool), k=-1)
    G = jnp.cumsum(g, axis=-1)
    decay = jnp.exp(jnp.where(causal, G[..., :, None] - G[..., None, :], -jnp.inf))
    kk = jnp.einsum('bhtd,bhsd->bhts', k, k)
    tri = jnp.where(strict, beta[..., :, None] * decay * kk, 0.0) + jnp.eye(c, dtype=F32)
    rhs = beta[..., None] * (v - jnp.exp(G)[..., None] * jnp.einsum('bhtd,bhde->bhte', k, S))
    delta = lax.linalg.triangular_solve(tri, rhs, left_side=True, lower=True, unit_diagonal=True)
    qk = jnp.einsum('bhtd,bhsd->bhts', q, k) * decay
    o = jnp.exp(G)[..., None] * jnp.einsum('bhtd,bhde->bhte', q, S) + jnp.einsum('bhts,bhse->bhte', qk, delta)
    g_last = G[..., -1:]
    S_new = jnp.exp(g_last)[..., None] * S + jnp.einsum('bhsd,bhse->bhde', k * jnp.exp(g_last - G)[..., None], delta)
    return S_new, o


def gated_delta_mix(q, k, v, g, beta, S0):
    bsz, L = q.shape[:2]
    c = min(L, CHUNK)
    nc = L // c

    def split(x):
        x = x.reshape((bsz, nc, c) + x.shape[2:])
        return jnp.moveaxis(jnp.moveaxis(x, 1, 0), 2, 3)

    S, o = lax.scan(lambda s, xs: gdn_chunk(s, *xs), S0, (split(q), split(k), split(v), split(g), split(beta)))
    o = jnp.moveaxis(jnp.moveaxis(o, 3, 2), 0, 1).reshape(bsz, L, D_HEADS, D_VAL_DIM)
    return o, S


def run_trunk(x, p, past_b_re, past_b_im, past_k_c, past_v_c, past_s_d, past_conv_d,
              norm_g, final_norm_g, ple_proj, ple_gate_w, ple_norm_g,
              even_w_in, even_w_out, a_ln_g, a_ln_b, a_w_s, a_b_s,
              b_lam_re, b_lam_im, b_log_dt, b_B_re, b_B_im, b_C_re, b_C_im, b_D, b_glu_w,
              odd_w_in, odd_w_out, d_conv_w, d_A_log, d_dt_bias, d_norm_g):
    bsz, L, _ = x.shape
    h = x
    nb_re, nb_im, na_v, nk, nv, ns, nconv = [], [], [], [], [], [], []
    for i in range(DEPTH):
        j = i // 2
        hn = rmsnorm(h, norm_g[i])
        if i % 2 == 0:
            proj = hn @ even_w_in[j]
            ua, va, za, ub, zb = jnp.split(
                proj, [A_WIDTH, 2 * A_WIDTH, 3 * A_WIDTH, 3 * A_WIDTH + B_WIDTH], axis=-1)
            ua = jax.nn.gelu(ua)
            va = layernorm(jax.nn.gelu(va), a_ln_g[j], a_ln_b[j])
            a_out = chunk_mlp_mix(ua, va, a_w_s[j], a_b_s[j]) * jax.nn.silu(za)
            if past_b_re is None:
                x0r = jnp.zeros((bsz, B_GROUPS, S5_STATE), F32)
                x0i = jnp.zeros((bsz, B_GROUPS, S5_STATE), F32)
            else:
                x0r, x0i = past_b_re[j], past_b_im[j]
            yb, xr, xi = s5_mix(ub, x0r, x0i, b_lam_re[j], b_lam_im[j], b_log_dt[j],
                                b_B_re[j], b_B_im[j], b_C_re[j], b_C_im[j], b_D[j])
            yb = jax.nn.gelu(yb)
            yb = yb * jax.nn.sigmoid(yb @ b_glu_w[j])
            b_out = yb * jax.nn.silu(zb)
            mix = jnp.concatenate([a_out, b_out], axis=-1) @ even_w_out[j]
            na_v.append(va)
            nb_re.append(xr)
            nb_im.append(xi)
        else:
            o1 = 4 * C_WIDTH
            o2 = o1 + D_CONV_CH
            o3 = o2 + D_WIDTH
            o4 = o3 + D_HEADS
            proj = hn @ odd_w_in[j]
            qc, kc, vc, zc, qkv_d, zd, a_d, b_d = jnp.split(
                proj, [C_WIDTH, 2 * C_WIDTH, 3 * C_WIDTH, o1, o2, o3, o4], axis=-1)
            qc = qc.reshape(bsz, L, C_HEADS, C_HEAD_DIM)
            kc = kc.reshape(bsz, L, C_HEADS, C_HEAD_DIM)
            vc = vc.reshape(bsz, L, C_HEADS, C_HEAD_DIM)
            if past_k_c is None:
                k_all, v_all, offset = kc, vc, 0
            else:
                pk, pv = past_k_c[j], past_v_c[j]
                k_all = jnp.concatenate([pk.astype(kc.dtype), kc], axis=1)
                v_all = jnp.concatenate([pv.astype(vc.dtype), vc], axis=1)
                offset = pk.shape[1]
            c_out = stick_breaking_attention(qc, k_all, v_all, offset) * jax.nn.silu(zc)
            if past_conv_d is None:
                buf = jnp.zeros((bsz, CONV_W - 1, D_CONV_CH), x.dtype)
                S0 = jnp.zeros((bsz, D_HEADS, D_KEY_DIM, D_VAL_DIM), F32)
            else:
                buf = past_conv_d[j]
                S0 = past_s_d[j].astype(F32)
            qkv_d, conv_new = causal_conv(qkv_d, buf, d_conv_w[j])
            qkv_d = jax.nn.silu(qkv_d)
            qd, kd, vd = jnp.split(qkv_d, [D_HEADS * D_KEY_DIM, 2 * D_HEADS * D_KEY_DIM], axis=-1)
            qd = l2norm(qd.reshape(bsz, L, D_HEADS, D_KEY_DIM)) * (D_KEY_DIM ** -0.5)
            kd = l2norm(kd.reshape(bsz, L, D_HEADS, D_KEY_DIM))
            vd = vd.reshape(bsz, L, D_HEADS, D_VAL_DIM).astype(F32)
            g = -jnp.exp(d_A_log[j].astype(F32)) * jax.nn.softplus(a_d.astype(F32) + d_dt_bias[j].astype(F32))
            beta = jax.nn.sigmoid(b_d.astype(F32))
            o_d, S = gated_delta_mix(qd, kd, vd, g, beta, S0)
            o_d = rmsnorm(o_d, d_norm_g[j]) * jax.nn.silu(zd.reshape(bsz, L, D_HEADS, D_VAL_DIM).astype(F32))
            d_out = o_d.reshape(bsz, L, D_WIDTH).astype(x.dtype)
            mix = jnp.concatenate([c_out, d_out], axis=-1) @ odd_w_out[j]
            nk.append(kc)
            nv.append(vc)
            ns.append(S)
            nconv.append(conv_new)
        h = h + mix
        gate = jax.nn.sigmoid(rmsnorm(h, ple_norm_g[i]) @ ple_gate_w[i])
        h = h + gate * (p[i] @ ple_proj[i])
    y = rmsnorm(h, final_norm_g)
    return (y, jnp.stack(nb_re), jnp.stack(nb_im), jnp.stack(na_v), jnp.stack(nk), jnp.stack(nv),
            jnp.stack(ns), jnp.stack(nconv))


def setup_inputs(seed: int = 0) -> dict:
    key = jax.random.key(seed)
    ks = iter(jax.random.split(key, 48))

    def nrm(shape, scale):
        return jax.random.normal(next(ks), shape, F32) * scale

    def unif(shape, lo, hi):
        return jax.random.uniform(next(ks), shape, F32, lo, hi)

    dt_d = jnp.exp(unif((N_ODD, D_HEADS), math.log(1e-3), math.log(1e-1)))
    return {
        'x_prompt': nrm((BATCH, SEQ, D_MODEL), 1.0),
        'x_sample': nrm((DEC_BATCH, DEC_SEQ, D_MODEL), 1.0),
        'state_b_re': nrm((N_EVEN, DEC_BATCH, B_GROUPS, S5_STATE), 0.5),
        'state_b_im': nrm((N_EVEN, DEC_BATCH, B_GROUPS, S5_STATE), 0.5),
        'cache_k_c': nrm((N_ODD, DEC_BATCH, PAST_LEN, C_HEADS, C_HEAD_DIM), 1.0),
        'cache_v_c': nrm((N_ODD, DEC_BATCH, PAST_LEN, C_HEADS, C_HEAD_DIM), 1.0),
        'state_d': nrm((N_ODD, DEC_BATCH, D_HEADS, D_KEY_DIM, D_VAL_DIM), 0.3),
        'state_conv_d': nrm((N_ODD, DEC_BATCH, CONV_W - 1, D_CONV_CH), 1.0),
        'p_prompt': nrm((DEPTH, BATCH, SEQ, PLE_DIM), 1.0),
        'p_sample': nrm((DEPTH, DEC_BATCH, DEC_SEQ, PLE_DIM), 1.0),
        'norm_g': 1.0 + nrm((DEPTH, D_MODEL), 0.02),
        'final_norm_g': 1.0 + nrm((D_MODEL,), 0.02),
        'ple_proj': nrm((DEPTH, PLE_DIM, D_MODEL), 0.5 * PLE_DIM ** -0.5),
        'ple_gate_w': nrm((DEPTH, D_MODEL, D_MODEL), D_MODEL ** -0.5),
        'ple_norm_g': 1.0 + nrm((DEPTH, D_MODEL), 0.02),
        'even_w_in': nrm((N_EVEN, D_MODEL, EVEN_IN), D_MODEL ** -0.5),
        'even_w_out': nrm((N_EVEN, EVEN_MIX, D_MODEL), 0.5 * EVEN_MIX ** -0.5),
        'a_ln_g': 1.0 + nrm((N_EVEN, A_WIDTH), 0.02),
        'a_ln_b': nrm((N_EVEN, A_WIDTH), 0.02),
        'a_w_s': nrm((N_EVEN, A_GROUPS, MLP_CHUNK, MLP_CHUNK), MLP_CHUNK ** -0.5),
        'a_b_s': 1.0 + nrm((N_EVEN, A_GROUPS, MLP_CHUNK), 0.1),
        'b_lam_re': -0.5 + nrm((N_EVEN, B_GROUPS, S5_STATE), 0.01),
        'b_lam_im': math.pi * jnp.arange(S5_STATE, dtype=F32) + nrm((N_EVEN, B_GROUPS, S5_STATE), 0.01),
        'b_log_dt': unif((N_EVEN, B_GROUPS), math.log(1e-3), math.log(1e-1)),
        'b_B_re': nrm((N_EVEN, B_GROUPS, S5_STATE, B_GROUP_DIM), (2 * B_GROUP_DIM) ** -0.5),
        'b_B_im': nrm((N_EVEN, B_GROUPS, S5_STATE, B_GROUP_DIM), (2 * B_GROUP_DIM) ** -0.5),
        'b_C_re': nrm((N_EVEN, B_GROUPS, B_GROUP_DIM, S5_STATE), S5_STATE ** -0.5),
        'b_C_im': nrm((N_EVEN, B_GROUPS, B_GROUP_DIM, S5_STATE), S5_STATE ** -0.5),
        'b_D': nrm((N_EVEN, B_GROUPS, B_GROUP_DIM), 0.5),
        'b_glu_w': nrm((N_EVEN, B_WIDTH, B_WIDTH), B_WIDTH ** -0.5),
        'odd_w_in': nrm((N_ODD, D_MODEL, ODD_IN), D_MODEL ** -0.5),
        'odd_w_out': nrm((N_ODD, ODD_MIX, D_MODEL), 0.5 * ODD_MIX ** -0.5),
        'd_conv_w': nrm((N_ODD, CONV_W, D_CONV_CH), CONV_W ** -0.5),
        'd_A_log': jnp.log(unif((N_ODD, D_HEADS), 1.0, 16.0)),
        'd_dt_bias': dt_d + jnp.log(-jnp.expm1(-dt_d)),
        'd_norm_g': 1.0 + nrm((N_ODD, D_VAL_DIM), 0.02),
    }


def reference(x_prompt, x_sample, state_b_re, state_b_im, cache_k_c, cache_v_c, state_d, state_conv_d,
              p_prompt, p_sample,
              norm_g, final_norm_g, ple_proj, ple_gate_w, ple_norm_g,
              even_w_in, even_w_out, a_ln_g, a_ln_b, a_w_s, a_b_s,
              b_lam_re, b_lam_im, b_log_dt, b_B_re, b_B_im, b_C_re, b_C_im, b_D, b_glu_w,
              odd_w_in, odd_w_out, d_conv_w, d_A_log, d_dt_bias, d_norm_g):
    y_prompt, b_re_p, b_im_p, _a_v_p, k_c_p, v_c_p, s_d_p, conv_d_p = run_trunk(
        x_prompt, p_prompt, None, None, None, None, None, None,
        norm_g, final_norm_g, ple_proj, ple_gate_w, ple_norm_g,
        even_w_in, even_w_out, a_ln_g, a_ln_b, a_w_s, a_b_s,
        b_lam_re, b_lam_im, b_log_dt, b_B_re, b_B_im, b_C_re, b_C_im, b_D, b_glu_w,
        odd_w_in, odd_w_out, d_conv_w, d_A_log, d_dt_bias, d_norm_g)
    y_sample, b_re_s, b_im_s, a_v_s, k_c_s, v_c_s, s_d_s, conv_d_s = run_trunk(
        x_sample, p_sample, state_b_re, state_b_im, cache_k_c, cache_v_c, state_d, state_conv_d,
        norm_g, final_norm_g, ple_proj, ple_gate_w, ple_norm_g,
        even_w_in, even_w_out, a_ln_g, a_ln_b, a_w_s, a_b_s,
        b_lam_re, b_lam_im, b_log_dt, b_B_re, b_B_im, b_C_re, b_C_im, b_D, b_glu_w,
        odd_w_in, odd_w_out, d_conv_w, d_A_log, d_dt_bias, d_norm_g)
    return (y_prompt, y_sample,
            b_re_p, b_im_p, k_c_p, v_c_p, s_d_p, conv_d_p,
            b_re_s, b_im_s, a_v_s, k_c_s, v_c_s, s_d_s, conv_d_s)
```

```cpp
#include <hip/hip_runtime.h>
#include <cstdio>
#include <cstdint>
#define GAS __attribute__((address_space(1)))
#define LAS __attribute__((address_space(3)))
__device__ __forceinline__ int fresh_tid(int wave_s) { int w_ = wave_s << 6; asm volatile("" : "+s"(w_)); return (int)__builtin_amdgcn_mbcnt_hi(~0u, __builtin_amdgcn_mbcnt_lo(~0u, (unsigned)w_)); }
typedef GAS unsigned gu32;
namespace pg8 {
#define PG8_LAS __attribute__((address_space(3)))
typedef unsigned short bf16_t;
typedef short bf16x8 __attribute__((ext_vector_type(8)));
typedef float f32x4 __attribute__((ext_vector_type(4)));
typedef unsigned u32x4 __attribute__((ext_vector_type(4)));
constexpr int BM = 256, BK = 64, HALF = 128, HTB = HALF * BK * 2  , STAGE_BYTES = 8 * HTB, NXCD = 8, WGM = 8;

__host__ __device__ __forceinline__ int lds_byte(int r, int c) { const int st = (r >> 4) * 2 + (c >> 5), rr = r & 15, cc = c & 31, ob = rr * 64 + cc * 2; return st * 1024 + (ob ^ (((ob >> 9) & 1) << 5)); }
__host__ __device__ __forceinline__ void stage_rc(int b, int& R, int& C) { const int st = b / 1024, sb = b % 1024, swz = sb ^ (((sb >> 9) & 1) << 5); R = (st >> 1) * 16 + swz / 64; C = (st & 1) * 32 + (swz % 64) / 2; }
__host__ __device__ __forceinline__ int perm32(int rho) { const int n = rho >> 4, i = rho & 15; return 8 * (i >> 2) + 4 * n + (i & 3); }

struct Unit { int pm, pn; };
struct Gemm { const bf16_t* A; const bf16_t* Bt; int M, N, K, lda, ldb; };

struct StaticOrder {
    int nM, nN, nwg, G, c, lo, hi;
    __host__ __device__ void init(int M, int N, int G_, int c_) { nM = M / BM; nN = N / BM; nwg = nM * nN; G = G_; c = c_; lo = 0; hi = nwg; }
    __host__ __device__ void init_range(int M, int N, int G_, int c_, int lo_, int hi_) { init(M, N, G_, c_); lo = lo_ < nwg ? lo_ : nwg; hi = hi_ < nwg ? hi_ : nwg; }
    __host__ __device__ bool next(int i, Unit& u) const {
        const long L = (long)i * G + c + lo; if (L >= hi) return false;
        int wgid = (int)L; { const int q = nwg / NXCD, r = nwg % NXCD, xcd = wgid % NXCD, off = wgid / NXCD; wgid = (xcd < r ? xcd * (q + 1) : r * (q + 1) + (xcd - r) * q) + off; }
        const int nig = WGM * nN, gid = wgid / nig, fm = gid * WGM, gsz = (nM - fm) < WGM ? (nM - fm) : WGM;
        u.pm = fm + ((wgid % nig) % gsz); u.pn = (wgid % nig) / gsz; return true;
    }
    __device__ __forceinline__ void a_ready(const Unit&) const {}
    __device__ __forceinline__ void done(const Unit&) const {}
};
struct FlagOrder : StaticOrder {
    unsigned* flag; unsigned need; int pm_wait;
    __device__ __forceinline__ void a_ready(const Unit& u) const {
        if (u.pm >= pm_wait) { unsigned sp = 0;
            while (__hip_atomic_load(flag, __ATOMIC_RELAXED, __HIP_MEMORY_SCOPE_AGENT) < need) { __builtin_amdgcn_s_sleep(2); if (++sp > (1u << 22)) break; }
            __builtin_amdgcn_fence(__ATOMIC_ACQUIRE, "agent"); }
    }
};

__device__ __forceinline__ unsigned cvt_pk_bf16(float lo, float hi) { unsigned r; asm volatile("v_cvt_pk_bf16_f32 %0, %1, %2" : "=v"(r) : "v"(lo), "v"(hi)); return r; }
typedef float f32x2 __attribute__((ext_vector_type(2)));
template <class Epi, class Sched, bool ALIGN_EPI = false, bool SP2 = false>
__device__ __forceinline__ void gemm_phase(PG8_LAS unsigned char* lds, const Gemm g, const Sched& S, const Epi& E, const int wave_s) {
    int tid_l = fresh_tid(wave_s); asm volatile("" : "+v"(tid_l));
    const int tid = tid_l, wid = __builtin_amdgcn_readfirstlane(tid >> 6), lane = tid & 63, wr = wid >> 2, wc = wid & 3, fr = lane & 15, fq = lane >> 4;
    const int K = g.K, nt = K / BK;
    unsigned voffA[2], voffB[2];
#pragma unroll
    for (int i = 0; i < 2; ++i) { int R, C; stage_rc(tid * 16 + i * 8192, R, C); const int Rb = Epi::PERM ? ((R & ~31) + perm32(R & 31)) : R;
        voffA[i] = (unsigned)(R * g.lda + C) * 2u; voffB[i] = (unsigned)(Rb * g.ldb + C) * 2u; }
    const size_t kstep = (size_t)(BK * 2);
    const size_t hstepA = (size_t)HALF * g.lda * 2, hstepB = (size_t)HALF * g.ldb * 2;
    const size_t tstepA = 2 * hstepA, tstepB = 2 * hstepB;
    const unsigned ldsw = (unsigned)wid * 1024u;
    const int aoff = lds_byte(wr * 64 + fr, fq * 8), boff = lds_byte(wc * 32 + fr, fq * 8);
#define PG8_SA(b, h) (((b) * 2 + (h)) * HTB)
#define PG8_SB(b, h) ((4 + (b) * 2 + (h)) * HTB)
#define PG8_STAGE(bufoff, gbase, voff) do { _Pragma("unroll") for (int _i = 0; _i < 2; ++_i) { unsigned _vo = (voff)[_i]; asm volatile("" : "+v"(_vo));     \
        __builtin_amdgcn_global_load_lds((const unsigned*)((const char*)(gbase) + _vo), (PG8_LAS unsigned*)(lds + (bufoff) + ldsw + _i * 8192), 16, 0, 0); } } while (0)
#define PG8_LDA(dst, b, h) do { _Pragma("unroll") for (int m = 0; m < 4; ++m) _Pragma("unroll") for (int k = 0; k < 2; ++k) dst[m][k] = *(const PG8_LAS bf16x8*)(lds + PG8_SA(b, h) + aoff + m * 2048 + k * 1024); } while (0)
#define PG8_LDB(dst, b, h) do { _Pragma("unroll") for (int n = 0; n < 2; ++n) _Pragma("unroll") for (int k = 0; k < 2; ++k) dst[n][k] = *(const PG8_LAS bf16x8*)(lds + PG8_SB(b, h) + boff + n * 2048 + k * 1024); } while (0)
#define PG8_MMA(ai, bj, At, Bt) do { __builtin_amdgcn_s_setprio(1); _Pragma("unroll") for (int m = 0; m < 4; ++m) _Pragma("unroll") for (int n = 0; n < 2; ++n) _Pragma("unroll") for (int k = 0; k < 2; ++k) \
        acc[ai][bj][m][n] = __builtin_amdgcn_mfma_f32_16x16x32_bf16(Bt[n][k], At[m][k], acc[ai][bj][m][n], 0, 0, 0); __builtin_amdgcn_s_setprio(0); } while (0)
#define PG8_WAIT_V(n) asm volatile("s_waitcnt vmcnt(" #n ")" ::: "memory")
#define PG8_WAIT_L(n) asm volatile("s_waitcnt lgkmcnt(" #n ")" ::: "memory")
#define PG8_BAR __builtin_amdgcn_s_barrier()
#define PG8_SCHED __builtin_amdgcn_sched_barrier(0)
    Unit cur, nxt; int ui = 0;
    if (!S.next(0, cur)) return;
    f32x4 acc[2][2][4][2];
#pragma unroll
    for (int a = 0; a < 2; ++a)
#pragma unroll
        for (int b = 0; b < 2; ++b)
#pragma unroll
            for (int m = 0; m < 4; ++m)
#pragma unroll
                for (int n = 0; n < 2; ++n) acc[a][b][m][n] = (f32x4){0.f, 0.f, 0.f, 0.f};
    bf16x8 At[4][2], B0[2][2], B1[2][2];
    const char* cA = (const char*)g.A + (size_t)cur.pm * tstepA; const char* cB = (const char*)g.Bt + (size_t)cur.pn * tstepB;
    S.a_ready(cur);
    if constexpr (SP2) {
        PG8_STAGE(PG8_SB(0, 0), cB, voffB); PG8_STAGE(PG8_SB(0, 1), cB + hstepB, voffB); PG8_STAGE(PG8_SA(0, 0), cA, voffA); PG8_STAGE(PG8_SA(0, 1), cA + hstepA, voffA);
        if (wr == 1) PG8_BAR;
        PG8_WAIT_V(2); PG8_BAR;
        PG8_STAGE(PG8_SB(1, 0), cB + kstep, voffB); PG8_STAGE(PG8_SA(1, 0), cA + kstep, voffA); PG8_STAGE(PG8_SB(1, 1), cB + hstepB + kstep, voffB);
        PG8_WAIT_V(6); PG8_BAR;
    } else {
        PG8_STAGE(PG8_SB(0, 0), cB, voffB); PG8_STAGE(PG8_SA(0, 0), cA, voffA); PG8_STAGE(PG8_SB(0, 1), cB + hstepB, voffB); PG8_STAGE(PG8_SA(0, 1), cA + hstepA, voffA);
        if (wr == 1) PG8_BAR;
        PG8_WAIT_V(4); PG8_BAR;
        PG8_STAGE(PG8_SB(1, 0), cB + kstep, voffB); PG8_STAGE(PG8_SA(1, 0), cA + kstep, voffA); PG8_STAGE(PG8_SB(1, 1), cB + hstepB + kstep, voffB);
        PG8_WAIT_V(6); PG8_BAR;
    }
    for (;;) {
        const bool has_next = S.next(ui + 1, nxt);
        const char* nA = has_next ? (const char*)g.A + (size_t)nxt.pm * tstepA : cA; const char* nB = has_next ? (const char*)g.Bt + (size_t)nxt.pn * tstepB : cB;
        for (int t = 0; t < nt; t += 2) {
            const bool last = (t == nt - 2);
            const char* a1 = cA + (size_t)(t + 1) * kstep;
            const char* a2 = last ? nA : cA + (size_t)(t + 2) * kstep; const char* b2 = last ? nB : cB + (size_t)(t + 2) * kstep;
            const char* a3 = a2 + kstep; const char* b3 = b2 + kstep;
            if (last && has_next) S.a_ready(nxt);
            if constexpr (SP2) {
            PG8_LDB(B0, 0, 0); PG8_LDB(B1, 0, 1); PG8_SCHED; PG8_LDA(At, 0, 0); PG8_STAGE(PG8_SA(1, 1), a1 + hstepA, voffA);
            PG8_WAIT_V(8); PG8_WAIT_L(0); PG8_BAR; PG8_MMA(0, 0, At, B0); PG8_MMA(0, 1, At, B1); PG8_BAR; PG8_SCHED;
            PG8_LDA(At, 0, 1); PG8_STAGE(PG8_SB(0, 0), b2, voffB); PG8_STAGE(PG8_SB(0, 1), b2 + hstepB, voffB); PG8_STAGE(PG8_SA(0, 0), a2, voffA);
            PG8_WAIT_V(8); PG8_WAIT_L(0); PG8_BAR; PG8_MMA(1, 0, At, B0); PG8_MMA(1, 1, At, B1); PG8_BAR; PG8_SCHED;
            PG8_LDB(B0, 1, 0); PG8_LDB(B1, 1, 1); PG8_SCHED; PG8_LDA(At, 1, 0); PG8_STAGE(PG8_SA(0, 1), a2 + hstepA, voffA);
            PG8_WAIT_V(8); PG8_WAIT_L(0); PG8_BAR; PG8_MMA(0, 0, At, B0); PG8_MMA(0, 1, At, B1); PG8_BAR; PG8_SCHED;
            PG8_LDA(At, 1, 1); PG8_STAGE(PG8_SB(1, 0), b3, voffB); PG8_STAGE(PG8_SB(1, 1), b3 + hstepB, voffB); PG8_STAGE(PG8_SA(1, 0), a3, voffA);
            PG8_WAIT_V(8); PG8_WAIT_L(0); PG8_BAR; PG8_MMA(1, 0, At, B0); PG8_MMA(1, 1, At, B1); PG8_BAR; PG8_SCHED;
            } else {
            PG8_LDB(B0, 0, 0); PG8_SCHED; PG8_LDA(At, 0, 0); PG8_STAGE(PG8_SA(1, 1), a1 + hstepA, voffA);
            PG8_WAIT_L(8); PG8_BAR; PG8_WAIT_L(0); PG8_MMA(0, 0, At, B0); PG8_BAR; PG8_SCHED;
            PG8_LDB(B1, 0, 1); PG8_STAGE(PG8_SB(0, 0), b2, voffB);
            PG8_BAR; PG8_WAIT_L(0); PG8_MMA(0, 1, At, B1); PG8_BAR;
            PG8_LDA(At, 0, 1); PG8_STAGE(PG8_SA(0, 0), a2, voffA);
            PG8_BAR; PG8_WAIT_L(0); PG8_MMA(1, 0, At, B0); PG8_BAR; PG8_SCHED;
            PG8_STAGE(PG8_SB(0, 1), b2 + hstepB, voffB);
            PG8_WAIT_V(6); PG8_BAR; PG8_MMA(1, 1, At, B1); PG8_BAR;
            PG8_LDB(B0, 1, 0); PG8_SCHED; PG8_LDA(At, 1, 0); PG8_STAGE(PG8_SA(0, 1), a2 + hstepA, voffA);
            PG8_WAIT_L(8); PG8_BAR; PG8_WAIT_L(0); PG8_MMA(0, 0, At, B0); PG8_BAR; PG8_SCHED;
            PG8_LDB(B1, 1, 1); PG8_STAGE(PG8_SB(1, 0), b3, voffB);
            PG8_BAR; PG8_WAIT_L(0); PG8_MMA(0, 1, At, B1); PG8_BAR;
            PG8_LDA(At, 1, 1); PG8_STAGE(PG8_SA(1, 0), a3, voffA);
            PG8_BAR; PG8_WAIT_L(0); PG8_MMA(1, 0, At, B0); PG8_BAR; PG8_SCHED;
            PG8_STAGE(PG8_SB(1, 1), b3 + hstepB, voffB);
            PG8_WAIT_V(6); PG8_BAR; PG8_MMA(1, 1, At, B1); PG8_BAR;
            }
        }
        if constexpr (ALIGN_EPI) { if (wr == 0) PG8_BAR; }
        if constexpr (!Epi::AFTER_DRAIN) { E(acc, cur, wr, wc, fr, fq); S.done(cur); }
        if (!has_next) break;
#pragma unroll
        for (int a = 0; a < 2; ++a)
#pragma unroll
            for (int b = 0; b < 2; ++b)
#pragma unroll
                for (int m = 0; m < 4; ++m)
#pragma unroll
                    for (int n = 0; n < 2; ++n) acc[a][b][m][n] = (f32x4){0.f, 0.f, 0.f, 0.f};
        cur = nxt; cA = nA; cB = nB; ++ui;
        if constexpr (ALIGN_EPI) { if (wr == 1) PG8_BAR; }
    }
    PG8_WAIT_V(0);
    if constexpr (!ALIGN_EPI) { if (wr == 0) PG8_BAR; }
    PG8_BAR;
    if constexpr (Epi::AFTER_DRAIN) { E.fused(acc, cur, wr, wc, fr, fq, lds, wid, lane); S.done(cur); }
#undef PG8_SA
#undef PG8_SB
#undef PG8_STAGE
#undef PG8_LDA
#undef PG8_LDB
#undef PG8_MMA
#undef PG8_WAIT_V
#undef PG8_WAIT_L
#undef PG8_BAR
#undef PG8_SCHED
}
}
#define XB_TMO      128
#define XB_XCNT(j)  (256  + 64 * (j))
#define XB_XSUB(j)  (1280 + 64 * (j))
#define XB_XGEN(j)  (2304 + 64 * (j))
#define XB_TOP      3328
#define XB_TOPGEN   3392
#define XCD_BAR_WORDS 3456
#define XB_SPIN_CAP (1u << 23)

__device__ __forceinline__ unsigned xb_ld(unsigned* p)              { return __hip_atomic_load(p, __ATOMIC_RELAXED, __HIP_MEMORY_SCOPE_AGENT); }
__device__ __forceinline__ unsigned xb_add(unsigned* p, unsigned v) { return __hip_atomic_fetch_add(p, v, __ATOMIC_RELAXED, __HIP_MEMORY_SCOPE_AGENT); }
__device__ __forceinline__ unsigned xb_xcc_id() { return (unsigned)__builtin_amdgcn_s_getreg((3 << 11) | 20) & 0xFu; }
#define XB_SPIN(cond, bar) do { unsigned _sp = 0; while (cond) { __builtin_amdgcn_s_sleep(1); \
    if ((++_sp & 255u) == 0u) { if (xb_ld(&(bar)[XB_TMO])) break; if (_sp > XB_SPIN_CAP) { atomicAdd(&(bar)[XB_TMO], 1u); break; } } } } while (0)

struct XcdBarrier {
    unsigned* bar; unsigned x;
    volatile LAS unsigned* st;
};

__device__ __forceinline__ XcdBarrier xcd_barrier_post(unsigned* bar, volatile LAS unsigned* st, const bool leader_wave) {
    XcdBarrier b; b.bar = bar; b.x = xb_xcc_id(); b.st = st;
    if (leader_wave && __builtin_amdgcn_mbcnt_lo(~0u, 0u) == 0u) (void)xb_add(&bar[XB_XCNT(b.x)], 1u);
    return b;
}
__device__ __forceinline__ void xcd_barrier_complete(unsigned* bar, unsigned x, unsigned& nloc, unsigned& nx) {
    const unsigned G = gridDim.x * gridDim.y * gridDim.z;
    unsigned sum, cnt, mine, sp = 0u;
    for (;;) {
        sum = 0u; cnt = 0u; mine = 0u;
#pragma unroll
        for (unsigned j = 0; j < 16; ++j) { const unsigned c = xb_ld(&bar[XB_XCNT(j)]); sum += c; cnt += (c > 0u) ? 1u : 0u; mine = (j == x) ? c : mine; }
        if (sum == G) break;
        __builtin_amdgcn_s_sleep(1);
        if ((++sp & 255u) == 0u) { if (xb_ld(&bar[XB_TMO])) break; if (sp > XB_SPIN_CAP) { atomicAdd(&bar[XB_TMO], 1u); break; } }
    }
    nloc = mine > 0u ? mine : 1u; nx = cnt > 0u ? cnt : 1u;
}

__device__ __forceinline__ void xcd_barrier(const XcdBarrier& b, const bool leader_wave) {
    asm volatile("s_waitcnt vmcnt(0)" ::: "memory");
    __syncthreads();
    if (leader_wave && __builtin_amdgcn_mbcnt_lo(~0u, 0u) == 0u) {
        unsigned* bar = b.bar;
        __builtin_amdgcn_s_waitcnt(0);
        unsigned nloc = b.st[0], nx = b.st[1];
        if (nloc == 0u) { xcd_barrier_complete(bar, b.x, nloc, nx); b.st[0] = nloc; b.st[1] = nx; }
        const unsigned old = xb_add(&bar[XB_XSUB(b.x)], 1u);
        const unsigned gen = old / nloc;
        if (old + 1u == (gen + 1u) * nloc) {
            __builtin_amdgcn_fence(__ATOMIC_RELEASE, "agent");
            asm volatile("s_waitcnt vmcnt(0)" ::: "memory");
            const unsigned og = xb_add(&bar[XB_TOP], 1u);
            const unsigned tg = og / nx;
            if (og + 1u == (tg + 1u) * nx) xb_add(&bar[XB_TOPGEN], 1u);
            else XB_SPIN(xb_ld(&bar[XB_TOPGEN]) == tg, bar);
            __builtin_amdgcn_fence(__ATOMIC_ACQUIRE, "agent");
            xb_add(&bar[XB_XGEN(b.x)], 1u);
            asm volatile("s_waitcnt vmcnt(0)" ::: "memory");
        } else {
            XB_SPIN(xb_ld(&bar[XB_XGEN(b.x)]) == gen, bar);
            __builtin_amdgcn_fence(__ATOMIC_ACQUIRE, "agent");
            asm volatile("s_waitcnt vmcnt(0)" ::: "memory");
        }
    }
    __syncthreads();
}
constexpr int NWAVES = 8, NTHR = 512;
constexpr int DM = 1024, MP = 65536, MS = 1024, MT = 66560;
constexpr int LP = 8192, LS = 64, NBP = 8, NBS = 16, PAST = 4096;
constexpr float EPSN = 1e-6f;
constexpr int N1 = 2560, N2 = 4352, ODD_IN = 4104;
constexpr int NCHP = 1024, NCH = 1040;
constexpr size_t O_YP = 0, O_YS = O_YP + (size_t)MP * DM, O_BREP = O_YS + (size_t)MS * DM, O_BIMP = O_BREP + 8 * 32 * 64,
    O_KCP = O_BIMP + 8 * 32 * 64, O_VCP = O_KCP + (size_t)MP * 512, O_SDP = O_VCP + (size_t)MP * 512, O_CONVP = O_SDP + 8 * 4 * 128 * 128,
    O_BRES = O_CONVP + 8 * 3 * 1536, O_BIMS = O_BRES + 16 * 32 * 64, O_AVS = O_BIMS + 16 * 32 * 64, O_KCS = O_AVS + (size_t)MS * 512,
    O_VCS = O_KCS + (size_t)MS * 512, O_SDS = O_VCS + (size_t)MS * 512, O_CONVS = O_SDS + 16 * 4 * 128 * 128, O_END = O_CONVS + 16 * 3 * 1536;
static_assert(O_END == 138620928ull, "output size");
constexpr size_t MiB = 1u << 20;
constexpr size_t WS_CTL = 0, CTL_ZERO_BYTES = 1 * MiB;
constexpr size_t WS_W1T = 1 * MiB, WS_WGLU = 7 * MiB, WS_WOUT0 = 8 * MiB, WS_WGATE0 = 10 * MiB, WS_WGATE1 = 12 * MiB, WS_WPLE0 = 14 * MiB, WS_WPLE1 = 15 * MiB,
    WS_W2T = 16 * MiB, WS_WOUT1 = 25 * MiB;
constexpr size_t WS_RSTD0 = 27 * MiB, WS_SSA = 28 * MiB, WS_SSB = 33 * MiB, WS_AB = 38 * MiB, WS_S5TAB = 41 * MiB, WS_S5E = 42 * MiB, WS_S5C = 50 * MiB, WS_DEG = 58 * MiB;
constexpr size_t WS_HBA = 64 * MiB, WS_MIXIN = 194 * MiB, WS_HBB = 324 * MiB, WS_PP = 454 * MiB, WS_PB = 584 * MiB, WS_R6 = 649 * MiB, WS_END = 1024 * MiB;
constexpr size_t WS_P0BUF = WS_R6, WS_YB = WS_R6 + 260 * MiB;
constexpr size_t WS_QZ = WS_R6, WS_DK = WS_R6 + 260 * MiB, WS_OD = WS_R6 + 325 * MiB;
constexpr size_t WS_QKVD = WS_HBB, WS_ZD = WS_HBB + 195 * MiB;
constexpr size_t WS_DA = WS_PB;
static_assert(WS_ZD + 65 * MiB == WS_PB && WS_OD <= WS_END, "ws map");
constexpr size_t WS_AWB = WS_S5TAB + 512 * 1024;
constexpr int T_AR = 0, T_AI = 2048, T_PR = 4096, T_PI = 6144, T_BBR = 8192, T_BBI = T_BBR + 32768;
constexpr int CW_BAR = 4096, CW_ATTN = 8192, CW_SGATE = 8256;
constexpr int LDS_BYTES = 147456, RING_BYTES = 131072, LDSCTL_OFF = LDS_BYTES - 1024, MISC_OFF = LDSCTL_OFF + 320;

typedef unsigned short bf16;
typedef unsigned v4u __attribute__((ext_vector_type(4)));
typedef unsigned v2u __attribute__((ext_vector_type(2)));
typedef float f32x4 __attribute__((ext_vector_type(4)));
typedef float f32x16 __attribute__((ext_vector_type(16)));
#define LDS_WAIT() asm volatile("s_waitcnt lgkmcnt(0)" ::: "memory")
#define VM_WAIT() asm volatile("s_waitcnt vmcnt(0)" ::: "memory")

__device__ __forceinline__ float bf2f(unsigned b) { return __uint_as_float(b << 16); }
typedef __bf16 bf2_t __attribute__((ext_vector_type(2)));
typedef float f2_t __attribute__((ext_vector_type(2)));
__device__ __forceinline__ unsigned pk2(float lo, float hi) { const f2_t v = {lo, hi}; const bf2_t b = __builtin_convertvector(v, bf2_t); return __builtin_bit_cast(unsigned, b); }
__device__ __forceinline__ unsigned f2bf(float f) { return pk2(f, f) & 0xffffu; }
__device__ __forceinline__ float bflo(unsigned w) { return __uint_as_float(w << 16); }
__device__ __forceinline__ float bfhi(unsigned w) { return __uint_as_float(w & 0xffff0000u); }
__device__ __forceinline__ float fsigmoid(float x) { return __builtin_amdgcn_rcpf(1.0f + __builtin_amdgcn_exp2f(x * -1.4426950408889634f)); }
__device__ __forceinline__ float fsig2(float x2) { return __builtin_amdgcn_rcpf(1.0f + __builtin_amdgcn_exp2f(x2)); }
__device__ __forceinline__ float fsilu(float x) { return x * fsigmoid(x); }
__device__ __forceinline__ float fgelu(float x) { const float x2 = x * x; return x * fsig2(x * (-2.302208198f - 0.1029432397f * x2)); }
__device__ __forceinline__ float fsoftplus(float x) { return fmaxf(x, 0.0f) + log1pf(__expf(-fabsf(x))); }
__device__ __forceinline__ float dpp_f(float v, const int ctrl_tag) {
    int r;
    if (ctrl_tag == 0) r = __builtin_amdgcn_update_dpp(0, __float_as_int(v), 0xB1, 0xf, 0xf, false);
    else if (ctrl_tag == 1) r = __builtin_amdgcn_update_dpp(0, __float_as_int(v), 0x4E, 0xf, 0xf, false);
    else if (ctrl_tag == 2) r = __builtin_amdgcn_update_dpp(0, __float_as_int(v), 0x141, 0xf, 0xf, false);
    else r = __builtin_amdgcn_update_dpp(0, __float_as_int(v), 0x140, 0xf, 0xf, false);
    return __int_as_float(r);
}
__device__ __forceinline__ float row16_sum(float v) { v += dpp_f(v, 0); v += dpp_f(v, 1); v += dpp_f(v, 2); v += dpp_f(v, 3); return v; }
typedef unsigned u2_t __attribute__((ext_vector_type(2)));
__device__ __forceinline__ float xor32f(float x) { const u2_t r = __builtin_amdgcn_permlane32_swap(__float_as_uint(x), __float_as_uint(x), false, false); return __uint_as_float(__builtin_amdgcn_inverse_ballot_w64(0xFFFFFFFF00000000ull) ? r.x : r.y); }
__device__ __forceinline__ float xor16f(float x) { const u2_t r = __builtin_amdgcn_permlane16_swap(__float_as_uint(x), __float_as_uint(x), false, false); return __uint_as_float(__builtin_amdgcn_inverse_ballot_w64(0xFFFF0000FFFF0000ull) ? r.x : r.y); }
__device__ __forceinline__ float wave_sum(float v) { v = row16_sum(v); v += xor16f(v); v += xor32f(v); return v; }
__device__ __forceinline__ const float* xrow_ptr(const float* xp, const float* xs, int m) { return m < MP ? xp + (size_t)m * DM : xs + (size_t)(m - MP) * DM; }
struct Args { const float* in[36]; float* out; unsigned char* ws; };
typedef const __attribute__((address_space(4))) Args CArgs;
#define ARGREF CArgs&
struct Frame {
    LAS unsigned char* lds;
    int tid, lane, wave, G, bid;
    const float* const* in;
};
#define IN_XP 0
#define IN_XS 1
#define IN_SBRE 2
#define IN_SBIM 3
#define IN_CK 4
#define IN_CV 5
#define IN_SD 6
#define IN_SCONV 7
#define IN_PP 8
#define IN_PS 9
#define IN_NORMG 10
#define IN_FNORMG 11
#define IN_PLEPROJ 12
#define IN_PLEGATE 13
#define IN_PLENORM 14
#define IN_EWIN 15
#define IN_EWOUT 16
#define IN_ALNG 17
#define IN_ALNB 18
#define IN_AWS 19
#define IN_ABS 20
#define IN_LAMRE 21
#define IN_LAMIM 22
#define IN_LOGDT 23
#define IN_BRE 24
#define IN_BIM 25
#define IN_CRE 26
#define IN_CIM 27
#define IN_BD 28
#define IN_GLUW 29
#define IN_OWIN 30
#define IN_OWOUT 31
#define IN_CONVW 32
#define IN_ALOG 33
#define IN_DTB 34
#define IN_DNORMG 35

__device__ __forceinline__ void p0_transpose_item(const float* W, int ldw, int K, int ncols_src, int scol0, bf16* WT, int n0, int k0, const float* kscale, LAS float* scr, int lane) {
    { float wv[32]; const int sc = scol0 + (lane & 31);
#pragma unroll
      for (int i = 0; i < 32; ++i) { const int kk = 2 * i + (lane >> 5); wv[i] = (sc < ncols_src) ? W[(size_t)(k0 + kk) * ldw + sc] : 0.0f; }
#pragma unroll
      for (int i = 0; i < 32; ++i) { const int kk = 2 * i + (lane >> 5); float v = wv[i]; if (kscale) v *= kscale[k0 + kk]; scr[kk * 33 + (lane & 31)] = v; } }
    LDS_WAIT(); asm volatile("" ::: "memory");
    const int c = lane & 7;
#pragma unroll
    for (int j = 0; j < 4; ++j) { const int n = (lane >> 3) + 8 * j; const LAS float* s = scr + (8 * c) * 33 + n;
        v4u o; o.x = pk2(s[0 * 33], s[1 * 33]); o.y = pk2(s[2 * 33], s[3 * 33]); o.z = pk2(s[4 * 33], s[5 * 33]); o.w = pk2(s[6 * 33], s[7 * 33]);
        *(v4u*)(WT + (size_t)(n0 + n) * K + k0 + 8 * c) = o; }
    LDS_WAIT(); asm volatile("" ::: "memory");
}
__device__ __forceinline__ void p0_transpose_mat(const float* W, int ldw, int K, int ncols_src, int Ndst, bf16* WT, const float* kscale, LAS float* scr, int& gwo, int NGW, int lane) {
    const int nblk = Ndst / 32, nitems = (K / 64) * nblk;
    int it = gwo;
    for (; it < nitems; it += NGW) { const int kb = it / nblk, nb = it % nblk; p0_transpose_item(W, ldw, K, ncols_src, 32 * nb, WT, 32 * nb, 64 * kb, kscale, scr, lane); }
    gwo = it - nitems;
}
__device__ __forceinline__ int w1_srccol(int n0) {
    const int j = n0 >> 8, c = n0 & 255;
    if (j < 4) return c < 128 ? 128 * j + c : 1024 + 128 * j + (c - 128);
    if (j < 6) return 512 + 256 * (j - 4) + c;
    if (j < 8) return 1536 + 256 * (j - 6) + c;
    return 2048 + 256 * (j - 8) + c;
}
__device__ __forceinline__ void p0_prologue(ARGREF A, Frame& F) {
    unsigned char* ws = A.ws;
    LAS float* scr = (LAS float*)(F.lds + F.wave * 16384);
    const int gw = F.bid * NWAVES + F.wave, NGW = F.G * NWAVES, lane = F.lane;
    int gwo = gw;
    { const int nblk = N1 / 32, nitems = (DM / 64) * nblk; int it = gwo;
      for (; it < nitems; it += NGW) { const int kb = it / nblk, nb = it % nblk; p0_transpose_item(A.in[IN_EWIN], N1, DM, N1, w1_srccol(32 * nb), (bf16*)(ws + WS_W1T), 32 * nb, 64 * kb, A.in[IN_NORMG], scr, lane); }
      gwo = it - nitems; }
    p0_transpose_mat(A.in[IN_GLUW], 512, 512, 512, 512, (bf16*)(ws + WS_WGLU), nullptr, scr, gwo, NGW, lane);
    p0_transpose_mat(A.in[IN_EWOUT], DM, DM, DM, DM, (bf16*)(ws + WS_WOUT0), nullptr, scr, gwo, NGW, lane);
    p0_transpose_mat(A.in[IN_PLEGATE], DM, DM, DM, DM, (bf16*)(ws + WS_WGATE0), A.in[IN_PLENORM], scr, gwo, NGW, lane);
    p0_transpose_mat(A.in[IN_PLEGATE] + (size_t)DM * DM, DM, DM, DM, DM, (bf16*)(ws + WS_WGATE1), A.in[IN_PLENORM] + DM, scr, gwo, NGW, lane);
    p0_transpose_mat(A.in[IN_PLEPROJ], DM, 256, DM, DM, (bf16*)(ws + WS_WPLE0), nullptr, scr, gwo, NGW, lane);
    p0_transpose_mat(A.in[IN_PLEPROJ] + (size_t)256 * DM, DM, 256, DM, DM, (bf16*)(ws + WS_WPLE1), nullptr, scr, gwo, NGW, lane);
    p0_transpose_mat(A.in[IN_OWIN], ODD_IN, DM, ODD_IN, N2, (bf16*)(ws + WS_W2T), A.in[IN_NORMG] + DM, scr, gwo, NGW, lane);
    p0_transpose_mat(A.in[IN_OWOUT], DM, DM, DM, DM, (bf16*)(ws + WS_WOUT1), nullptr, scr, gwo, NGW, lane);
    { bf16* XB = (bf16*)(ws + WS_HBA); float* RS = (float*)(ws + WS_RSTD0);
      for (int m = 2 * gw; m < MT; m += 2 * NGW) {
        f32x4 v[2][4];
#pragma unroll
        for (int k = 0; k < 2; ++k) { const f32x4* xr = (const f32x4*)xrow_ptr(A.in[IN_XP], A.in[IN_XS], m + k) + lane;
#pragma unroll
            for (int j = 0; j < 4; ++j) v[k][j] = xr[64 * j]; }
#pragma unroll
        for (int k = 0; k < 2; ++k) { float s = 0.f;
#pragma unroll
            for (int j = 0; j < 4; ++j) s += (v[k][j].x * v[k][j].x + v[k][j].y * v[k][j].y) + (v[k][j].z * v[k][j].z + v[k][j].w * v[k][j].w);
            s = wave_sum(s);
            v2u* o8 = (v2u*)(XB + (size_t)(m + k) * DM) + lane;
#pragma unroll
            for (int j = 0; j < 4; ++j) { v2u w; w.x = pk2(v[k][j].x, v[k][j].y); w.y = pk2(v[k][j].z, v[k][j].w); o8[64 * j] = w; }
            if (lane == 0) RS[m + k] = 1.0f / sqrtf(s * (1.0f / DM) + EPSN); }
      } }
    { bf16* PB = (bf16*)(ws + WS_PB);
#pragma unroll
      for (int seg = 0; seg < 4; ++seg) { const int i = seg >> 1; const bool smp = seg & 1;
          const f32x4* src = (const f32x4*)(smp ? A.in[IN_PS] + (size_t)i * MS * 256 : A.in[IN_PP] + (size_t)i * MP * 256);
          v2u* dst = (v2u*)(PB + ((size_t)i * MT + (smp ? MP : 0)) * 256);
          const int nchunk = (smp ? MS : MP) * 64 / 512;
          for (int c = gw; c < nchunk; c += NGW) { f32x4 v[8]; const f32x4* s = src + (size_t)c * 512 + lane; v2u* d = dst + (size_t)c * 512 + lane;
#pragma unroll
              for (int k = 0; k < 8; ++k) v[k] = s[64 * k];
#pragma unroll
              for (int k = 0; k < 8; ++k) { v2u w; w.x = pk2(v[k].x, v[k].y); w.y = pk2(v[k].z, v[k].w); d[64 * k] = w; } } } }
    { bf16* WB = (bf16*)(ws + WS_AWB); const int gt = F.bid * NTHR + F.tid, gs_ = F.G * NTHR;
      for (int q = gt; q < 4 * 128 * 128 / 2; q += gs_) { const int e = 2 * q, t = (e >> 7) & 127, s = e & 127; const float a = A.in[IN_AWS][e], b = A.in[IN_AWS][e + 1];
        *(unsigned*)(WB + e) = pk2(s <= t ? a : 0.f, s + 1 <= t ? b : 0.f); } }
    { float* T = (float*)(ws + WS_S5TAB); const int gt = F.bid * NTHR + F.tid, gs = F.G * NTHR;
      for (int q = gt; q < 2048; q += gs) { const int g = q >> 6;
        const float dt = expf(A.in[IN_LOGDT][g]); const float lr = A.in[IN_LAMRE][q], li = A.in[IN_LAMIM][q];
        const float mag = expf(lr * dt); float sn, cs; sincosf(li * dt, &sn, &cs);
        const float ar = mag * cs, ai = mag * sn; const float den = lr * lr + li * li;
        const float cr = ((ar - 1.0f) * lr + ai * li) / den, ci = (ai * lr - (ar - 1.0f) * li) / den;
        T[T_AR + q] = ar; T[T_AI + q] = ai;
        float pr = ar, pi = ai;
#pragma unroll
        for (int k = 0; k < 7; ++k) { const float nr = pr * pr - pi * pi, ni = 2.0f * pr * pi; pr = nr; pi = ni; }
        T[T_PR + q] = pr; T[T_PI + q] = pi;
        for (int p = 0; p < 16; ++p) { const float br = A.in[IN_BRE][q * 16 + p], bi = A.in[IN_BIM][q * 16 + p];
            T[T_BBR + q * 16 + p] = cr * br - ci * bi; T[T_BBI + q * 16 + p] = cr * bi + ci * br; } } }
}

typedef pg8::f32x4 pf4;
__device__ __forceinline__ v4u pack8(const pf4 a, const pf4 b) { v4u w; w.x = pk2(a[0], a[1]); w.y = pk2(a[2], a[3]); w.z = pk2(b[0], b[1]); w.w = pk2(b[2], b[3]); return w; }
__device__ __forceinline__ void unpack8(const v4u w, float (&o)[8]) { o[0] = bflo(w.x); o[1] = bfhi(w.x); o[2] = bflo(w.y); o[3] = bfhi(w.y); o[4] = bflo(w.z); o[5] = bfhi(w.z); o[6] = bflo(w.w); o[7] = bfhi(w.w); }

struct Epi1 {
    static constexpr bool PERM = true, AFTER_DRAIN = false;
    bf16* P0; const float* rstd;
    __device__ __forceinline__ void operator()(const pf4 (&acc)[2][2][4][2], const pg8::Unit& u, int wr, int wc, int fr, int fq) const {
        asm volatile("" : "+v"(fr), "+v"(fq));
        const int row0 = u.pm * 256 + wr * 64 + fr, pn = u.pn;
        float rsv[2][4];
#pragma unroll
        for (int ai = 0; ai < 2; ++ai)
#pragma unroll
            for (int m = 0; m < 4; ++m) rsv[ai][m] = rstd[row0 + ai * 128 + m * 16];
#pragma unroll
        for (int ai = 0; ai < 2; ++ai)
#pragma unroll
            for (int m = 0; m < 4; ++m) { const int row = row0 + ai * 128 + m * 16; const float rs = rsv[ai][m]; bf16* rp = P0 + (size_t)row * 2048;
                if (pn < 4) {
                    pf4 a, b;
#pragma unroll
                    for (int j = 0; j < 4; ++j) { a[j] = fgelu(acc[ai][0][m][0][j] * rs) * fsilu(acc[ai][1][m][0][j] * rs); b[j] = fgelu(acc[ai][0][m][1][j] * rs) * fsilu(acc[ai][1][m][1][j] * rs); }
                    *(v4u*)(rp + 128 * pn + 32 * wc + 8 * fq) = pack8(a, b);
                } else {
#pragma unroll
                    for (int bj = 0; bj < 2; ++bj) { pf4 a = acc[ai][bj][m][0] * rs, b = acc[ai][bj][m][1] * rs;
                        if (pn < 6) {
#pragma unroll
                            for (int j = 0; j < 4; ++j) { a[j] = fgelu(a[j]); b[j] = fgelu(b[j]); }
                        } else if (pn >= 8) {
#pragma unroll
                            for (int j = 0; j < 4; ++j) { a[j] = fsilu(a[j]); b[j] = fsilu(b[j]); }
                        }
                        *(v4u*)(rp + 512 + 256 * (pn - 4) + 128 * bj + 32 * wc + 8 * fq) = pack8(a, b); }
                }
                asm volatile("" ::: "memory"); }
    }
};
struct EpiPlain {
    static constexpr bool PERM = true, AFTER_DRAIN = false;
    bf16* O; int ldc;
    __device__ __forceinline__ void operator()(const pf4 (&acc)[2][2][4][2], const pg8::Unit& u, int wr, int wc, int fr, int fq) const {
        asm volatile("" : "+v"(fr), "+v"(fq));
        const int row0 = u.pm * 256 + wr * 64 + fr, col0 = u.pn * 256 + 32 * wc + 8 * fq;
#pragma unroll
        for (int ai = 0; ai < 2; ++ai)
#pragma unroll
            for (int m = 0; m < 4; ++m) { bf16* rp = O + (size_t)(row0 + ai * 128 + m * 16) * ldc + col0;
#pragma unroll
                for (int bj = 0; bj < 2; ++bj) *(v4u*)(rp + 128 * bj) = pack8(acc[ai][bj][m][0], acc[ai][bj][m][1]); }
    }
};
struct EpiGlu {
    static constexpr bool PERM = true, AFTER_DRAIN = false;
    const bf16* YB; const bf16* P0; bf16* MIX;
    __device__ __forceinline__ void operator()(const pf4 (&acc)[2][2][4][2], const pg8::Unit& u, int wr, int wc, int fr, int fq) const {
        asm volatile("" : "+v"(fr), "+v"(fq));
        const int row0 = u.pm * 256 + wr * 64 + fr, col0 = u.pn * 256 + 32 * wc + 8 * fq;
#pragma unroll
        for (int ai = 0; ai < 2; ++ai) {
            v4u yv[4][2], zv[4][2];
#pragma unroll
            for (int m = 0; m < 4; ++m)
#pragma unroll
                for (int bj = 0; bj < 2; ++bj) { const int row = row0 + ai * 128 + m * 16, col = col0 + 128 * bj;
                    yv[m][bj] = *(const v4u*)(YB + (size_t)row * 512 + col); zv[m][bj] = *(const v4u*)(P0 + (size_t)row * 2048 + 1536 + col); }
#pragma unroll
            for (int m = 0; m < 4; ++m) { const int row = row0 + ai * 128 + m * 16;
#pragma unroll
                for (int bj = 0; bj < 2; ++bj) { const int col = col0 + 128 * bj;
                    float y[8], z[8]; unpack8(yv[m][bj], y); unpack8(zv[m][bj], z);
                    pf4 a, b;
#pragma unroll
                    for (int j = 0; j < 4; ++j) { a[j] = y[j] * fsig2(acc[ai][bj][m][0][j] * -1.4426950408889634f) * z[j]; b[j] = y[4 + j] * fsig2(acc[ai][bj][m][1][j] * -1.4426950408889634f) * z[4 + j]; }
                    *(v4u*)(MIX + (size_t)row * DM + 512 + col) = pack8(a, b); } }
            asm volatile("" ::: "memory"); }
    }
};
template <bool XF> struct EpiRes {
    static constexpr bool PERM = true, AFTER_DRAIN = false;
    const float* xp; const float* xs; const bf16* HIN; bf16* HOUT; float* SS;
    __device__ __forceinline__ void operator()(const pf4 (&acc)[2][2][4][2], const pg8::Unit& u, int wr, int wc, int fr, int fq) const {
        asm volatile("" : "+v"(fr), "+v"(fq));
        const int row0 = u.pm * 256 + wr * 64 + fr, col0 = u.pn * 256 + 32 * wc + 8 * fq;
#pragma unroll
        for (int ai = 0; ai < 2; ++ai) {
            f32x4 xv[4][2][2]; v4u hv[4][2];
#pragma unroll
            for (int m = 0; m < 4; ++m)
#pragma unroll
                for (int bj = 0; bj < 2; ++bj) { const int row = row0 + ai * 128 + m * 16, col = col0 + 128 * bj;
                    if (XF) { const float* xr = xrow_ptr(xp, xs, row) + col; xv[m][bj][0] = *(const f32x4*)xr; xv[m][bj][1] = *(const f32x4*)(xr + 4); }
                    else hv[m][bj] = *(const v4u*)(HIN + (size_t)row * DM + col); }
#pragma unroll
            for (int m = 0; m < 4; ++m) { const int row = row0 + ai * 128 + m * 16; float sq = 0.f;
#pragma unroll
                for (int bj = 0; bj < 2; ++bj) { const int col = col0 + 128 * bj; float b[8];
                    if (XF) { const f32x4 x0 = xv[m][bj][0], x1 = xv[m][bj][1]; b[0] = x0.x; b[1] = x0.y; b[2] = x0.z; b[3] = x0.w; b[4] = x1.x; b[5] = x1.y; b[6] = x1.z; b[7] = x1.w; }
                    else unpack8(hv[m][bj], b);
                    pf4 a, c;
#pragma unroll
                    for (int j = 0; j < 4; ++j) { a[j] = b[j] + acc[ai][bj][m][0][j]; c[j] = b[4 + j] + acc[ai][bj][m][1][j]; }
                    *(v4u*)(HOUT + (size_t)row * DM + col) = pack8(a, c);
#pragma unroll
                    for (int j = 0; j < 4; ++j) sq += a[j] * a[j] + c[j] * c[j]; }
                sq += xor16f(sq); sq += xor32f(sq);
                if (fq == 0) SS[(size_t)row * 16 + u.pn * 4 + wc] = sq; }
            asm volatile("" ::: "memory"); }
    }
};
__device__ __forceinline__ float row_rstd16(const float* SS, int row, int fq) {
    const f32x4 v = *(const f32x4*)(SS + (size_t)row * 16 + 4 * fq); float s = (v.x + v.y) + (v.z + v.w);
    s += xor16f(s); s += xor32f(s);
    return 1.0f / sqrtf(s * (1.0f / DM) + EPSN);
}
template <bool FINAL> struct EpiGate {
    static constexpr bool PERM = true, AFTER_DRAIN = false;
    const bf16* HIN; const bf16* PPB; const float* SSin; bf16* HOUT; float* SSout; float* yp; float* ys;
    __device__ __forceinline__ void operator()(const pf4 (&acc)[2][2][4][2], const pg8::Unit& u, int wr, int wc, int fr, int fq) const {
        asm volatile("" : "+v"(fr), "+v"(fq));
        const int row0 = u.pm * 256 + wr * 64 + fr, col0 = u.pn * 256 + 32 * wc + 8 * fq;
#pragma unroll
        for (int ai = 0; ai < 2; ++ai) {
            v4u hv[4][2], pv[4][2]; f32x4 sv[4];
#pragma unroll
            for (int m = 0; m < 4; ++m) { const int row = row0 + ai * 128 + m * 16; sv[m] = *(const f32x4*)(SSin + (size_t)row * 16 + 4 * fq);
#pragma unroll
                for (int bj = 0; bj < 2; ++bj) { const int col = col0 + 128 * bj; hv[m][bj] = *(const v4u*)(HIN + (size_t)row * DM + col); pv[m][bj] = *(const v4u*)(PPB + (size_t)row * DM + col); } }
#pragma unroll
            for (int m = 0; m < 4; ++m) { const int row = row0 + ai * 128 + m * 16;
                float ssum = (sv[m].x + sv[m].y) + (sv[m].z + sv[m].w); ssum += xor16f(ssum); ssum += xor32f(ssum);
                const float rs = (1.0f / sqrtf(ssum * (1.0f / DM) + EPSN)) * -1.4426950408889634f; float sq = 0.f;
#pragma unroll
                for (int bj = 0; bj < 2; ++bj) { const int col = col0 + 128 * bj; float h[8], p[8];
                    unpack8(hv[m][bj], h); unpack8(pv[m][bj], p);
                    pf4 a, c;
#pragma unroll
                    for (int j = 0; j < 4; ++j) { a[j] = h[j] + fsig2(rs * acc[ai][bj][m][0][j]) * p[j]; c[j] = h[4 + j] + fsig2(rs * acc[ai][bj][m][1][j]) * p[4 + j]; }
                    if (FINAL) { float* yr = (row < MP ? yp + (size_t)row * DM : ys + (size_t)(row - MP) * DM) + col; *(f32x4*)yr = (f32x4){a[0], a[1], a[2], a[3]}; *(f32x4*)(yr + 4) = (f32x4){c[0], c[1], c[2], c[3]};
#pragma unroll
                        for (int j = 0; j < 4; ++j) sq += a[j] * a[j] + c[j] * c[j]; }
                    else { *(v4u*)(HOUT + (size_t)row * DM + col) = pack8(a, c);
#pragma unroll
                        for (int j = 0; j < 4; ++j) sq += a[j] * a[j] + c[j] * c[j]; } }
                sq += xor16f(sq); sq += xor32f(sq);
                if (fq == 0) SSout[(size_t)row * 16 + u.pn * 4 + wc] = sq; }
            asm volatile("" ::: "memory"); }
    }
};
struct Epi2 {
    static constexpr bool PERM = true, AFTER_DRAIN = false;
    const float* SSin; bf16* QZ; bf16* QKVD; bf16* ZD; float* AB; float* out;
    __device__ __forceinline__ void operator()(const pf4 (&acc)[2][2][4][2], const pg8::Unit& u, int wr, int wc, int fr, int fq) const {
        asm volatile("" : "+v"(fr), "+v"(fq));
        const int row0 = u.pm * 256 + wr * 64 + fr, pn = u.pn, cl0 = 32 * wc + 8 * fq;
        f32x4 sv[2][4];
#pragma unroll
        for (int ai = 0; ai < 2; ++ai)
#pragma unroll
            for (int m = 0; m < 4; ++m) sv[ai][m] = *(const f32x4*)(SSin + (size_t)(row0 + ai * 128 + m * 16) * 16 + 4 * fq);
#pragma unroll
        for (int ai = 0; ai < 2; ++ai)
#pragma unroll
            for (int m = 0; m < 4; ++m) { const int row = row0 + ai * 128 + m * 16;
                float ssum = (sv[ai][m].x + sv[ai][m].y) + (sv[ai][m].z + sv[ai][m].w); ssum += xor16f(ssum); ssum += xor32f(ssum);
                const float rs = 1.0f / sqrtf(ssum * (1.0f / DM) + EPSN);
                const bool samp = row >= MP; const int rl = samp ? row - MP : row;
                if (pn == 16) { if (wc == 0 && fq == 0) { const pf4 a = acc[ai][0][m][0] * rs, b = acc[ai][0][m][1] * rs; *(f32x4*)(AB + (size_t)row * 8) = (f32x4){a[0], a[1], a[2], a[3]}; *(f32x4*)(AB + (size_t)row * 8 + 4) = (f32x4){b[0], b[1], b[2], b[3]}; } continue; }
#pragma unroll
                for (int bj = 0; bj < 2; ++bj) { const int cl = cl0 + 128 * bj; pf4 a = acc[ai][bj][m][0] * rs, b = acc[ai][bj][m][1] * rs;
                    if (pn < 2) { a = a * (0.125f * 1.4426950408889634f); b = b * (0.125f * 1.4426950408889634f);     *(v4u*)(QZ + (size_t)row * 2048 + 256 * pn + cl) = pack8(a, b); }
                    else if (pn < 6) { const int c = 256 * (pn & 1) + cl; float* o = out + (pn < 4 ? (samp ? O_KCS : O_KCP) : (samp ? O_VCS : O_VCP)) + (size_t)rl * 512 + c;
                        *(f32x4*)o = (f32x4){a[0], a[1], a[2], a[3]}; *(f32x4*)(o + 4) = (f32x4){b[0], b[1], b[2], b[3]};
                        *(v4u*)(QZ + (size_t)row * 2048 + 256 * pn + cl) = pack8(a, b); }
                    else if (pn < 8) {
#pragma unroll
                        for (int j = 0; j < 4; ++j) { a[j] = fsilu(a[j]); b[j] = fsilu(b[j]); }
                        *(v4u*)(QZ + (size_t)row * 2048 + 256 * pn + cl) = pack8(a, b); }
                    else if (pn < 14) { const int c = 256 * (pn - 8) + cl; *(v4u*)(QKVD + (size_t)row * 1536 + c) = pack8(a, b);
                        const int L = samp ? LS : LP, t = rl % L, bb = rl / L;
                        if (t >= L - 3) { float* o = out + (samp ? O_CONVS : O_CONVP) + ((size_t)bb * 3 + (t - (L - 3))) * 1536 + c; *(f32x4*)o = (f32x4){a[0], a[1], a[2], a[3]}; *(f32x4*)(o + 4) = (f32x4){b[0], b[1], b[2], b[3]}; } }
                    else {
#pragma unroll
                        for (int j = 0; j < 4; ++j) { a[j] = fsilu(a[j]); b[j] = fsilu(b[j]); }
                        *(v4u*)(ZD + (size_t)row * 512 + 256 * (pn - 14) + cl) = pack8(a, b); } }
                asm volatile("" ::: "memory"); }
    }
};
__device__ __forceinline__ void chunk128_rows(int ch, int& m0, int& nrows) { if (ch < 512) { m0 = ch * 128; nrows = 128; } else { m0 = MP + (ch - 512) * 64; nrows = 64; } }

constexpr int AB_PITCH = 272, AB_IMG = 128 * AB_PITCH;
typedef short ab_b8 __attribute__((ext_vector_type(8)));
__device__ __forceinline__ void a_branch_unit(ARGREF A, Frame& F, int ch, int gp) {
    const bf16* P0 = (const bf16*)(A.ws + WS_P0BUF); bf16* MIX = (bf16*)(A.ws + WS_MIXIN); const bf16* WB = (const bf16*)(A.ws + WS_AWB);
    int m0, nrows; chunk128_rows(ch, m0, nrows);
    const int lane = F.lane, wave = F.wave, l31 = lane & 31, hh = lane >> 5;
    { float gg[8], gb[8];
#pragma unroll
      for (int j = 0; j < 8; ++j) { gg[j] = A.in[IN_ALNG][8 * lane + j]; gb[j] = A.in[IN_ALNB][8 * lane + j]; }
      for (int r = wave; r < nrows; r += 2 * NWAVES) {
          v4u raw[2];
#pragma unroll
          for (int k = 0; k < 2; ++k) raw[k] = *(const v4u*)(P0 + (size_t)(m0 + r + 8 * k) * 2048 + 512 + 8 * lane);
#pragma unroll
          for (int k = 0; k < 2; ++k) { const int rr = r + 8 * k, m = m0 + rr; float v[8]; unpack8(raw[k], v);
              float s = 0.f;
#pragma unroll
              for (int j = 0; j < 8; ++j) s += v[j];
              const float mean = wave_sum(s) * (1.0f / 512.0f); float q = 0.f;
#pragma unroll
              for (int j = 0; j < 8; ++j) { v[j] -= mean; q += v[j] * v[j]; }
              const float rstd = 1.0f / sqrtf(wave_sum(q) * (1.0f / 512.0f) + EPSN);
#pragma unroll
              for (int j = 0; j < 8; ++j) v[j] = v[j] * rstd * gg[j] + gb[j];
              if ((lane >> 5) == gp) *(LAS v4u*)(F.lds + ((lane >> 4) & 1) * AB_IMG + rr * AB_PITCH + 16 * (lane & 15)) = (v4u){pk2(v[0], v[1]), pk2(v[2], v[3]), pk2(v[4], v[5]), pk2(v[6], v[7])};
              if (gp == 0 && m >= MP) { float* o = A.out + O_AVS + (size_t)(m - MP) * 512 + 8 * lane; *(f32x4*)o = (f32x4){v[0], v[1], v[2], v[3]}; *(f32x4*)(o + 4) = (f32x4){v[4], v[5], v[6], v[7]}; } } } }
    __syncthreads();
    const int gl = wave >> 2, c = wave & 3, g = 2 * gp + gl; const int nt = nrows >> 5;
    f32x16 acc[4];
#pragma unroll
    for (int i = 0; i < 4; ++i)
#pragma unroll
        for (int r = 0; r < 16; ++r) acc[i][r] = 0.f;
    const unsigned trb = (unsigned)(gl * AB_IMG + (8 * hh + ((lane & 15) >> 2)) * AB_PITCH + (32 * c + 16 * ((lane >> 4) & 1) + 4 * (lane & 3)) * 2);
    const bf16* wrow = WB + (size_t)g * 16384 + (size_t)l31 * 128 + 8 * hh;
#pragma unroll
    for (int ks = 0; ks < 8; ++ks) if (ks < 2 * nt) {
        v2u t0, t1;
        asm volatile("ds_read_b64_tr_b16 %0, %1" : "=v"(t0) : "v"(trb + (unsigned)(16 * ks * AB_PITCH)) : "memory");
        asm volatile("ds_read_b64_tr_b16 %0, %1" : "=v"(t1) : "v"(trb + (unsigned)((16 * ks + 4) * AB_PITCH)) : "memory");
        ab_b8 af[4];
#pragma unroll
        for (int i = 0; i < 4; ++i) if (i >= (ks >> 1) && i < nt) af[i] = __builtin_bit_cast(ab_b8, *(const v4u*)(wrow + i * 4096 + 16 * ks));
        asm volatile("s_waitcnt lgkmcnt(0)" : "+v"(t0), "+v"(t1) :: "memory");
        const ab_b8 bf = __builtin_bit_cast(ab_b8, (v4u){t0.x, t0.y, t1.x, t1.y});
#pragma unroll
        for (int i = 0; i < 4; ++i) if (i >= (ks >> 1) && i < nt) acc[i] = __builtin_amdgcn_mfma_f32_32x32x16_bf16(af[i], bf, acc[i], 0, 0, 0);
    }
    const float* bsv = A.in[IN_ABS] + g * 128;
#pragma unroll
    for (int i = 0; i < 4; ++i) if (i < nt) {
#pragma unroll
        for (int r = 0; r < 16; ++r) { const int t = 32 * i + 8 * (r >> 2) + 4 * hh + (r & 3); const size_t m = (size_t)(m0 + t);
            const float uz = bf2f(P0[m * 2048 + 128 * g + 32 * c + l31]);
            MIX[m * DM + 128 * g + 32 * c + l31] = (bf16)f2bf(uz * (acc[i][r] + bsv[t])); } }
    __syncthreads();
}

constexpr int S5_XROW = 80, S5_WLDS = 128 * S5_XROW;
typedef short s5_b8 __attribute__((ext_vector_type(8)));
template <int PASS> __device__ __forceinline__ void s5_unit(ARGREF A, Frame& F, int ch, int g, unsigned xt_off) {
    const bf16* P0 = (const bf16*)(A.ws + WS_P0BUF); const float* T = (const float*)(A.ws + WS_S5TAB);
    int m0, nrows; chunk128_rows(ch, m0, nrows);
    const int lane = fresh_tid(F.wave) & 63, l31 = lane & 31, hh = lane >> 5, l15 = lane & 15, kq = lane >> 4;
    s5_b8 bfr[2][2]; float ar[2], ai[2], cr[2], ci[2], p16r[2], p16i[2];
#pragma unroll
    for (int c = 0; c < 2; ++c) { const int q = g * 64 + 32 * c + l31;
        const float* pr = T + T_BBR + q * 16 + 8 * hh; const float* pi = T + T_BBI + q * 16 + 8 * hh;
        { const f32x4 a = *(const f32x4*)pr, b = *(const f32x4*)(pr + 4); const v4u w = {pk2(a.x, a.y), pk2(a.z, a.w), pk2(b.x, b.y), pk2(b.z, b.w)}; bfr[c][0] = __builtin_bit_cast(s5_b8, w); }
        { const f32x4 a = *(const f32x4*)pi, b = *(const f32x4*)(pi + 4); const v4u w = {pk2(a.x, a.y), pk2(a.z, a.w), pk2(b.x, b.y), pk2(b.z, b.w)}; bfr[c][1] = __builtin_bit_cast(s5_b8, w); }
        ar[c] = T[T_AR + q]; ai[c] = T[T_AI + q];
        { float pr = ar[c], pi = ai[c];
#pragma unroll
          for (int k = 0; k < 4; ++k) { const float nr = pr * pr - pi * pi, ni = 2.0f * pr * pi; pr = nr; pi = ni; }
          p16r[c] = pr; p16i[c] = pi; }
        cr[c] = 0.f; ci[c] = 0.f;
        if (PASS == 2) {
            if (ch < 512) { const float* C = (const float*)(A.ws + WS_S5C) + ((size_t)ch * 2048 + q) * 2; cr[c] = C[0]; ci[c] = C[1]; }
            else { const int b = ch - 512; cr[c] = A.in[IN_SBRE][(size_t)b * 2048 + q]; ci[c] = A.in[IN_SBIM][(size_t)b * 2048 + q]; } } }
    s5_b8 cfr[4]; float dsk = 0.f;
    if (PASS == 2) {
#pragma unroll
        for (int ks = 0; ks < 4; ++ks) { const int k0 = 32 * ks + 8 * kq; const bool im = k0 >= 64;
            const float* cp = (im ? A.in[IN_CIM] : A.in[IN_CRE]) + ((size_t)g * 16 + l15) * 64 + (k0 & 63); const float sg = im ? -1.f : 1.f;
            const f32x4 a = *(const f32x4*)cp, b = *(const f32x4*)(cp + 4);
            const v4u w = {pk2(sg * a.x, sg * a.y), pk2(sg * a.z, sg * a.w), pk2(sg * b.x, sg * b.y), pk2(sg * b.z, sg * b.w)}; cfr[ks] = __builtin_bit_cast(s5_b8, w); }
        dsk = A.in[IN_BD][g * 16 + l15]; }
    const int tperm = 16 * ((l31 >> 2) & 1) + 4 * (l31 >> 3) + (l31 & 3);
    const unsigned trb = xt_off + (unsigned)((8 * kq + (l15 >> 2)) * S5_XROW + 8 * (l15 & 3));
    v4u ufa[4];
#pragma unroll
    for (int tt = 0; tt < 4; ++tt) if (tt < nrows / 32) ufa[tt] = *(const v4u*)(P0 + (size_t)(m0 + 32 * tt + tperm) * 2048 + 1024 + 16 * g + 8 * hh);
    unsigned short uun[8];
    if (PASS == 2) {
#pragma unroll
        for (int q = 0; q < 8; ++q) uun[q] = P0[(size_t)(m0 + 16 * (q >> 2) + 4 * kq + (q & 3)) * 2048 + 1024 + 16 * g + l15]; }
#pragma unroll
    for (int tt = 0; tt < 4; ++tt) if (tt < nrows / 32) {
        const int mt = m0 + 32 * tt;
        const s5_b8 uf = __builtin_bit_cast(s5_b8, ufa[tt]);
        unsigned short uuc[8];
        if (PASS == 2) {
#pragma unroll
            for (int q = 0; q < 8; ++q) uuc[q] = uun[q];
            if (tt + 1 < nrows / 32) {
#pragma unroll
                for (int q = 0; q < 8; ++q) uun[q] = P0[(size_t)(mt + 32 + 16 * (q >> 2) + 4 * kq + (q & 3)) * 2048 + 1024 + 16 * g + l15]; } }
        f32x16 xr[2], xi[2];
#pragma unroll
        for (int c = 0; c < 2; ++c) { f32x16 zz;
#pragma unroll
            for (int r = 0; r < 16; ++r) zz[r] = 0.f;
            xr[c] = __builtin_amdgcn_mfma_f32_32x32x16_bf16(uf, bfr[c][0], zz, 0, 0, 0); xi[c] = __builtin_amdgcn_mfma_f32_32x32x16_bf16(uf, bfr[c][1], zz, 0, 0, 0); }
#pragma unroll
        for (int c = 0; c < 2; ++c) {
            float er = hh == 0 ? cr[c] : 0.f, ei = hh == 0 ? ci[c] : 0.f;
#pragma unroll
            for (int r = 0; r < 16; ++r) { const float nr = ar[c] * er - ai[c] * ei + xr[c][r], ni = ar[c] * ei + ai[c] * er + xi[c][r]; er = nr; ei = ni; }
            const float per_ = xor32f(er), pei_ = xor32f(ei);
            const float c1r = hh ? per_ : er, c1i = hh ? pei_ : ei;
            if (PASS == 1) {
                const float z1r = hh ? er : per_, z1i = hh ? ei : pei_;
                cr[c] = z1r + (p16r[c] * c1r - p16i[c] * c1i); ci[c] = z1i + (p16r[c] * c1i + p16i[c] * c1r);
                continue; }
            float sr = hh == 0 ? cr[c] : c1r, si = hh == 0 ? ci[c] : c1i;
#pragma unroll
            for (int r = 0; r < 16; ++r) { const float nr = ar[c] * sr - ai[c] * si + xr[c][r], ni = ar[c] * si + ai[c] * sr + xi[c][r]; sr = nr; si = ni; xr[c][r] = sr; xi[c][r] = si; }
            { const float psr_ = xor32f(sr), psi_ = xor32f(si); cr[c] = hh ? sr : psr_; ci[c] = hh ? si : psi_; }
        }
        if (PASS == 2) {
#pragma unroll
            for (int c = 0; c < 2; ++c)
#pragma unroll
                for (int part = 0; part < 2; ++part) { const f32x16& x = part ? xi[c] : xr[c];
                    LAS unsigned char* dst = F.lds + xt_off + (64 * part + 32 * c + l31) * S5_XROW + 32 * hh;
                    *(LAS v4u*)dst = (v4u){pk2(x[0], x[1]), pk2(x[2], x[3]), pk2(x[4], x[5]), pk2(x[6], x[7])};
                    *(LAS v4u*)(dst + 16) = (v4u){pk2(x[8], x[9]), pk2(x[10], x[11]), pk2(x[12], x[13]), pk2(x[14], x[15])}; }
            asm volatile("s_waitcnt lgkmcnt(0)" ::: "memory");
            bf16* YB = (bf16*)(A.ws + WS_YB);
#pragma unroll
            for (int t16 = 0; t16 < 2; ++t16) {
                v2u tr[4][2];
#pragma unroll
                for (int ks = 0; ks < 4; ++ks)
#pragma unroll
                    for (int tp = 0; tp < 2; ++tp) asm volatile("ds_read_b64_tr_b16 %0, %1" : "=v"(tr[ks][tp]) : "v"(trb + (unsigned)((32 * ks + 4 * tp) * S5_XROW + 32 * t16)) : "memory");
                asm volatile("s_waitcnt lgkmcnt(0)" : "+v"(tr[0][0]), "+v"(tr[0][1]), "+v"(tr[1][0]), "+v"(tr[1][1]), "+v"(tr[2][0]), "+v"(tr[2][1]), "+v"(tr[3][0]), "+v"(tr[3][1]) :: "memory");
                pf4 acc = {0.f, 0.f, 0.f, 0.f};
#pragma unroll
                for (int ks = 0; ks < 4; ++ks) { const s5_b8 af = __builtin_bit_cast(s5_b8, (v4u){tr[ks][0].x, tr[ks][0].y, tr[ks][1].x, tr[ks][1].y});
                    acc = __builtin_amdgcn_mfma_f32_16x16x32_bf16(af, cfr[ks], acc, 0, 0, 0); }
#pragma unroll
                for (int r = 0; r < 4; ++r) { const int m = mt + 16 * t16 + 4 * kq + r; const float uu = bf2f(uuc[4 * t16 + r]);
                    YB[(size_t)m * 512 + 16 * g + l15] = (bf16)f2bf(fgelu(acc[r] + dsk * uu)); }
            }
        }
    }
    if (hh == 0) {
        int ln_ = (int)__builtin_amdgcn_mbcnt_lo(~0u, 0u); asm volatile("" : "+v"(ln_));
#pragma unroll
        for (int c = 0; c < 2; ++c) { const int q = g * 64 + 32 * c + ln_;
            if (PASS == 1) { float* E = (float*)(A.ws + WS_S5E) + ((size_t)ch * 2048 + q) * 2; E[0] = cr[c]; E[1] = ci[c]; }
            else if (ch >= 512) { const int b = ch - 512; A.out[O_BRES + (size_t)b * 2048 + q] = cr[c]; A.out[O_BIMS + (size_t)b * 2048 + q] = ci[c]; } } }
}
__device__ __forceinline__ void s5_carry(ARGREF A, Frame& F) {
    const float* T = (const float*)(A.ws + WS_S5TAB); const float* E = (const float*)(A.ws + WS_S5E); float* C = (float*)(A.ws + WS_S5C);
    for (int i = F.bid * NTHR + F.tid; i < 8 * 2048; i += F.G * NTHR) { const int b = i >> 11, q = i & 2047;
        const float pr = T[T_PR + q], pi = T[T_PI + q]; float xr = 0.f, xi = 0.f;
        for (int c = 0; c < 64; ++c) { const size_t o = ((size_t)(b * 64 + c) * 2048 + q) * 2; C[o] = xr; C[o + 1] = xi;
            const float er = E[o], ei = E[o + 1]; const float nr = pr * xr - pi * xi + er, ni = pr * xi + pi * xr + ei; xr = nr; xi = ni; }
        A.out[O_BREP + (size_t)b * 2048 + q] = xr; A.out[O_BIMP + (size_t)b * 2048 + q] = xi; }
}
constexpr float SB_CUT = -104.0f * 1.4426950408889634f;
constexpr int AT_VROW = 192, AT_WLDS = 32 * AT_VROW;
typedef short at_b8 __attribute__((ext_vector_type(8)));
__device__ __forceinline__ v4u at_cvt8(const f32x4 a, const f32x4 b) { v4u w; w.x = pk2(a.x, a.y); w.y = pk2(a.z, a.w); w.z = pk2(b.x, b.y); w.w = pk2(b.z, b.w); return w; }
__device__ __forceinline__ void attn_unit(ARGREF A, Frame& F, int unit) {
    const int qt_g = unit >> 3, hd = unit & 7, lane = F.lane, l31 = lane & 31, hh = lane >> 5;
    const int m0 = qt_g * 32;
    const bool samp = m0 >= MP; const int rl0 = samp ? m0 - MP : m0; const int L = samp ? LS : LP; const int b = rl0 / L, t0 = rl0 % L;
    const bf16* QZ = (const bf16*)(A.ws + WS_QZ);
    const unsigned vbase = (unsigned)(F.wave * AT_WLDS);
    at_b8 qf[4];
#pragma unroll
    for (int ks = 0; ks < 4; ++ks) qf[ks] = __builtin_bit_cast(at_b8, *(const v4u*)(QZ + (size_t)(m0 + l31) * 2048 + 64 * hd + 16 * ks + 8 * hh));
    f32x16 O0, O1;
#pragma unroll
    for (int r = 0; r < 16; ++r) { O0[r] = 0.f; O1[r] = 0.f; }
    float carry = 0.f;
    const int brow0 = m0 - t0;
    const int n_new = t0 / 32 + 1, n_tiles = n_new + (samp ? PAST / 32 : 0);
    const float* Kc = A.in[IN_CK] + (size_t)b * PAST * 512 + 64 * hd; const float* Vc = A.in[IN_CV] + (size_t)b * PAST * 512 + 64 * hd;
    const unsigned tr0 = vbase + (unsigned)((4 * hh + ((lane & 15) >> 2)) * AT_VROW + (16 * ((lane >> 4) & 1) + 4 * (lane & 3)) * 2);
    for (int it = 0; it < n_tiles; ++it) {
        const bool from_cache = it >= n_new; const bool diag = it == 0;
        at_b8 kf[4];
        if (!from_cache) {
            const int k0 = brow0 + (n_new - 1 - it) * 32;
#pragma unroll
            for (int ks = 0; ks < 4; ++ks) kf[ks] = __builtin_bit_cast(at_b8, *(const v4u*)(QZ + (size_t)(k0 + l31) * 2048 + 512 + 64 * hd + 16 * ks + 8 * hh));
            const bf16* vp = QZ + (size_t)(k0 + (lane >> 1)) * 2048 + 1024 + 64 * hd + (lane & 1) * 32;
            v4u vv[4];
#pragma unroll
            for (int i = 0; i < 4; ++i) vv[i] = *(const v4u*)(vp + 8 * i);
#pragma unroll
            for (int i = 0; i < 4; ++i) *(LAS v4u*)(F.lds + vbase + (lane >> 1) * AT_VROW + (lane & 1) * 64 + 16 * i) = vv[i];
        } else {
            const int s0 = (n_tiles - 1 - it) * 32;
            const float* kp = Kc + (size_t)(s0 + l31) * 512 + 8 * hh;
#pragma unroll
            for (int ks = 0; ks < 4; ++ks) kf[ks] = __builtin_bit_cast(at_b8, at_cvt8(*(const f32x4*)(kp + 16 * ks), *(const f32x4*)(kp + 16 * ks + 4)));
            const float* vp = Vc + (size_t)(s0 + (lane >> 1)) * 512 + (lane & 1) * 32;
            f32x4 vf[8];
#pragma unroll
            for (int i = 0; i < 8; ++i) vf[i] = *(const f32x4*)(vp + 4 * i);
#pragma unroll
            for (int i = 0; i < 4; ++i) *(LAS v4u*)(F.lds + vbase + (lane >> 1) * AT_VROW + (lane & 1) * 64 + 16 * i) = at_cvt8(vf[2 * i], vf[2 * i + 1]);
        }
        f32x16 z;
#pragma unroll
        for (int r = 0; r < 16; ++r) z[r] = 0.f;
#pragma unroll
        for (int ks = 0; ks < 4; ++ks) z = __builtin_amdgcn_mfma_f32_32x32x16_bf16(kf[ks], qf[ks], z, 0, 0, 0);
        float lk[16];
#pragma unroll
        for (int r = 0; r < 16; ++r) { const float zz = z[r]; float v = -(fmaxf(zz, 0.f) + __builtin_amdgcn_logf(1.0f + __builtin_amdgcn_exp2f(-fabsf(zz))));
            if (diag) { const int key = 8 * (r >> 2) + 4 * hh + (r & 3); if (key >= l31) v = 0.f; }
            lk[r] = v; }
        float R[4], P[4];
#pragma unroll
        for (int g = 0; g < 4; ++g) { R[g] = (lk[4 * g] + lk[4 * g + 1]) + (lk[4 * g + 2] + lk[4 * g + 3]); P[g] = xor32f(R[g]); }
        float sg = carry;
        at_b8 wf[2];
        { unsigned wpk[8];
#pragma unroll
          for (int g = 3; g >= 0; --g) { float aft = sg + (hh == 0 ? P[g] : 0.f); float w4[4];
#pragma unroll
              for (int e = 3; e >= 0; --e) { const int r = 4 * g + e; float w = __builtin_amdgcn_exp2f(lk[r] + z[r] + aft);
                  if (diag) { const int key = 8 * g + 4 * hh + e; if (key >= l31) w = 0.f; }
                  w4[e] = w; aft += lk[r]; }
              wpk[2 * g] = pk2(w4[0], w4[1]); wpk[2 * g + 1] = pk2(w4[2], w4[3]);
              sg += R[g] + P[g]; }
          wf[0] = __builtin_bit_cast(at_b8, (v4u){wpk[0], wpk[1], wpk[2], wpk[3]}); wf[1] = __builtin_bit_cast(at_b8, (v4u){wpk[4], wpk[5], wpk[6], wpk[7]}); }
        carry = sg;
        v2u vr[2][2][2];
#pragma unroll
        for (int s2 = 0; s2 < 2; ++s2)
#pragma unroll
            for (int c = 0; c < 2; ++c)
#pragma unroll
                for (int t = 0; t < 2; ++t) asm volatile("ds_read_b64_tr_b16 %0, %1" : "=v"(vr[s2][c][t]) : "v"(tr0 + (unsigned)((16 * s2 + 8 * t) * AT_VROW + 64 * c)) : "memory");
        asm volatile("s_waitcnt lgkmcnt(0)" : "+v"(vr[0][0][0]), "+v"(vr[0][0][1]), "+v"(vr[0][1][0]), "+v"(vr[0][1][1]), "+v"(vr[1][0][0]), "+v"(vr[1][0][1]), "+v"(vr[1][1][0]), "+v"(vr[1][1][1]) :: "memory");
#pragma unroll
        for (int s2 = 0; s2 < 2; ++s2) {
            const at_b8 vb0 = __builtin_bit_cast(at_b8, (v4u){vr[s2][0][0].x, vr[s2][0][0].y, vr[s2][0][1].x, vr[s2][0][1].y});
            const at_b8 vb1 = __builtin_bit_cast(at_b8, (v4u){vr[s2][1][0].x, vr[s2][1][0].y, vr[s2][1][1].x, vr[s2][1][1].y});
            O0 = __builtin_amdgcn_mfma_f32_32x32x16_bf16(wf[s2], vb0, O0, 0, 0, 0);
            O1 = __builtin_amdgcn_mfma_f32_32x32x16_bf16(wf[s2], vb1, O1, 0, 0, 0); }
        if (__all(carry <= SB_CUT)) break;
    }
    bf16* MIX = (bf16*)(A.ws + WS_MIXIN);
#pragma unroll
    for (int r = 0; r < 16; ++r) { const int m = m0 + 8 * (r >> 2) + 4 * hh + (r & 3);
        const float z0 = bf2f(QZ[(size_t)m * 2048 + 1536 + 64 * hd + l31]), z1 = bf2f(QZ[(size_t)m * 2048 + 1536 + 64 * hd + 32 + l31]);
        MIX[(size_t)m * DM + 64 * hd + l31] = (bf16)f2bf(O0[r] * z0); MIX[(size_t)m * DM + 64 * hd + 32 + l31] = (bf16)f2bf(O1[r] * z1); }
}

__device__ __forceinline__ int chunk64_row0(int cg) { return cg < NCHP ? cg * 64 : MP + (cg - NCHP) * 64; }
constexpr int DP_XQ = 0, DP_XK = 33792, DP_TRI = 0, DP_TB = 17408, DP_AQL = 26624, DP_TF = 35840;
constexpr int DP_QB = 67584, DP_KB = 84992, DP_RT = 102400, DP_GS = 139264;
constexpr int DP_RB = 272, DP_TP = 144;
typedef short dp_b8 __attribute__((ext_vector_type(8)));
__device__ __forceinline__ void dn_prep_unit(ARGREF A, Frame& F, int cg, int h) {
    const bf16* QKVD = (const bf16*)(A.ws + WS_QKVD); const float* AB = (const float*)(A.ws + WS_AB);
    bf16* DW = (bf16*)((unsigned char*)A.out);
    bf16* DU = DW + (size_t)NCH * 4 * 64 * 128; bf16* DQ = DU + (size_t)NCH * 4 * 64 * 128;
    bf16* DK = (bf16*)(A.ws + WS_DK); bf16* DA = (bf16*)(A.ws + WS_DA); float* DEG = (float*)(A.ws + WS_DEG);
    LAS float* qs = (LAS float*)(F.lds + DP_XQ); LAS float* ks = (LAS float*)(F.lds + DP_XK);
    LAS float* tri = (LAS float*)(F.lds + DP_TRI); LAS float* tf = (LAS float*)(F.lds + DP_TF); LAS float* gs = (LAS float*)(F.lds + DP_GS);
    const int tid = F.tid, lane = F.lane, wave = F.wave, l15 = lane & 15, kq = lane >> 4;
    const int m0 = chunk64_row0(cg); const bool samp = cg >= NCHP; const int bs = cg - NCHP; const int cidx = cg * 4 + h;
    const bool first = samp || (cg % 128 == 0);
    const float* cw = A.in[IN_CONVW];
    if (wave == 0) { const int m = m0 + lane; const float a = AB[(size_t)m * 8 + h], bb = AB[(size_t)m * 8 + 4 + h];
        float g = -expf(A.in[IN_ALOG][h]) * fsoftplus(a + A.in[IN_DTB][h]); gs[64 + lane] = fsigmoid(bb);
#pragma unroll
        for (int o = 1; o < 64; o <<= 1) { const float v = __shfl_up(g, o); if (lane >= o) g += v; }
        gs[lane] = g; }
    __syncthreads();
    if (tid < 384) { const int cg8 = tid % 48, rseg = tid / 48; const int part = cg8 >> 4, d8 = (cg8 & 15) * 8; const int col = part * 512 + h * 128 + d8;
        float xw[11][8];
#pragma unroll
        for (int i = 0; i < 11; ++i) { const int tt = 8 * rseg - 3 + i;
            if (tt >= 0 || !first) unpack8(*(const v4u*)(QKVD + (size_t)(m0 + tt) * 1536 + col), xw[i]);
            else if (samp) { const float* sp = A.in[IN_SCONV] + ((size_t)bs * 3 + (3 + tt)) * 1536 + col; const f32x4 a = *(const f32x4*)sp, c = *(const f32x4*)(sp + 4);
                xw[i][0] = a.x; xw[i][1] = a.y; xw[i][2] = a.z; xw[i][3] = a.w; xw[i][4] = c.x; xw[i][5] = c.y; xw[i][6] = c.z; xw[i][7] = c.w; }
            else {
#pragma unroll
                for (int j = 0; j < 8; ++j) xw[i][j] = 0.f; } }
        float w[4][8];
#pragma unroll
        for (int i = 0; i < 4; ++i) { const f32x4 a = *(const f32x4*)(cw + i * 1536 + col), c = *(const f32x4*)(cw + i * 1536 + col + 4);
            w[i][0] = a.x; w[i][1] = a.y; w[i][2] = a.z; w[i][3] = a.w; w[i][4] = c.x; w[i][5] = c.y; w[i][6] = c.z; w[i][7] = c.w; }
        float y[8][8];
#pragma unroll
        for (int r = 0; r < 8; ++r)
#pragma unroll
            for (int j = 0; j < 8; ++j) y[r][j] = fsilu(xw[r][j] * w[0][j] + xw[r + 1][j] * w[1][j] + xw[r + 2][j] * w[2][j] + xw[r + 3][j] * w[3][j]);
        if (part < 2) { LAS float* dst = (part == 0 ? qs : ks) + d8;
#pragma unroll
            for (int r = 0; r < 8; ++r) { *(LAS f32x4*)(dst + (8 * rseg + r) * 132) = (f32x4){y[r][0], y[r][1], y[r][2], y[r][3]}; *(LAS f32x4*)(dst + (8 * rseg + r) * 132 + 4) = (f32x4){y[r][4], y[r][5], y[r][6], y[r][7]}; } }
        else { float bt[8];
#pragma unroll
            for (int r = 0; r < 8; ++r) bt[r] = gs[64 + 8 * rseg + r];
#pragma unroll
            for (int j = 0; j < 8; ++j) *(LAS v4u*)(F.lds + DP_RT + (d8 + j) * DP_TP + 16 * rseg) = (v4u){pk2(bt[0] * y[0][j], bt[1] * y[1][j]), pk2(bt[2] * y[2][j], bt[3] * y[3][j]), pk2(bt[4] * y[4][j], bt[5] * y[5][j]), pk2(bt[6] * y[6][j], bt[7] * y[7][j])}; }
    }
    __syncthreads();
    for (int r = wave * 8; r < wave * 8 + 8; ++r) {
        float a0 = qs[r * 132 + lane], a1 = qs[r * 132 + 64 + lane]; float s = wave_sum(a0 * a0 + a1 * a1); float sc = (1.0f / sqrtf(s + EPSN)) * 0.08838834764831845f;
        qs[r * 132 + lane] = a0 * sc; qs[r * 132 + 64 + lane] = a1 * sc;
        a0 = ks[r * 132 + lane]; a1 = ks[r * 132 + 64 + lane]; s = wave_sum(a0 * a0 + a1 * a1); sc = 1.0f / sqrtf(s + EPSN);
        ks[r * 132 + lane] = a0 * sc; ks[r * 132 + 64 + lane] = a1 * sc; }
    __syncthreads();
    { const float Gl = gs[63];
      for (int idx = tid; idx < 64 * 16; idx += NTHR) { const int t = idx >> 4, d8 = (idx & 15) * 8; const float eg = __expf(gs[t]);
          const f32x4 a = *(const LAS f32x4*)(qs + t * 132 + d8), c = *(const LAS f32x4*)(qs + t * 132 + d8 + 4);
          *(LAS v4u*)(F.lds + DP_QB + t * DP_RB + 2 * d8) = (v4u){pk2(a.x, a.y), pk2(a.z, a.w), pk2(c.x, c.y), pk2(c.z, c.w)};
          *(v4u*)(DQ + (size_t)cidx * 8192 + t * 128 + d8) = (v4u){pk2(a.x * eg, a.y * eg), pk2(a.z * eg, a.w * eg), pk2(c.x * eg, c.y * eg), pk2(c.z * eg, c.w * eg)};
          const f32x4 ka = *(const LAS f32x4*)(ks + t * 132 + d8), kc = *(const LAS f32x4*)(ks + t * 132 + d8 + 4);
          *(LAS v4u*)(F.lds + DP_KB + t * DP_RB + 2 * d8) = (v4u){pk2(ka.x, ka.y), pk2(ka.z, ka.w), pk2(kc.x, kc.y), pk2(kc.z, kc.w)}; }
      for (int idx = tid; idx < 128 * 8; idx += NTHR) { const int d = idx & 127, s8 = (idx >> 7) * 8; float v[8], u[8];
#pragma unroll
          for (int j = 0; j < 8; ++j) { const float kv = ks[(s8 + j) * 132 + d], Gs = gs[s8 + j]; v[j] = kv * __expf(Gl - Gs); u[j] = kv * gs[64 + s8 + j] * __expf(Gs); }
          *(v4u*)(DK + (size_t)cidx * 8192 + d * 64 + s8) = (v4u){pk2(v[0], v[1]), pk2(v[2], v[3]), pk2(v[4], v[5]), pk2(v[6], v[7])};
          *(LAS v4u*)(F.lds + DP_RT + (128 + d) * DP_TP + 2 * s8) = (v4u){pk2(u[0], u[1]), pk2(u[2], u[3]), pk2(u[4], u[5]), pk2(u[6], u[7])}; }
      if (tid == 0) DEG[cidx] = __expf(Gl); }
    __syncthreads();
    { const int mat = wave >> 2, mt = wave & 3;
      dp_b8 af[4];
#pragma unroll
      for (int ksp = 0; ksp < 4; ++ksp) af[ksp] = __builtin_bit_cast(dp_b8, *(const LAS v4u*)(F.lds + (mat ? DP_QB : DP_KB) + (16 * mt + l15) * DP_RB + 64 * ksp + 16 * kq));
      pf4 acc[4];
#pragma unroll
      for (int nt = 0; nt < 4; ++nt) { acc[nt] = (pf4){0.f, 0.f, 0.f, 0.f};
#pragma unroll
          for (int ksp = 0; ksp < 4; ++ksp) acc[nt] = __builtin_amdgcn_mfma_f32_16x16x32_bf16(af[ksp], __builtin_bit_cast(dp_b8, *(const LAS v4u*)(F.lds + DP_KB + (16 * nt + l15) * DP_RB + 64 * ksp + 16 * kq)), acc[nt], 0, 0, 0); }
      __syncthreads();
#pragma unroll
      for (int nt = 0; nt < 4; ++nt) { const int s = 16 * nt + l15; const float Gs = gs[s];
#pragma unroll
          for (int r = 0; r < 4; ++r) { const int t = 16 * mt + 4 * kq + r; const float dec = (s <= t) ? __expf(gs[t] - Gs) : 0.f;
              if (mat == 0) tri[t * 68 + s] = (s < t) ? gs[64 + t] * dec * acc[nt][r] : 0.f;
              else *(LAS unsigned short*)(F.lds + DP_AQL + t * DP_TP + 2 * s) = (unsigned short)f2bf(acc[nt][r] * dec); } }
      for (int idx = tid; idx < 64 * 64; idx += NTHR) tf[(idx >> 6) * 68 + (idx & 63)] = ((idx >> 6) == (idx & 63)) ? 1.f : 0.f; }
    __syncthreads();
    if (wave == 0) { const int blk = lane >> 5, cc = lane & 31; LAS float* buf = tf + (32 * blk) * 68 + 32 * blk + cc; const LAS float* tb = tri + (32 * blk) * 68 + 32 * blk;
        for (int I = 0; I < 4; ++I) {
            float acc[8];
#pragma unroll
            for (int i = 0; i < 8; ++i) acc[i] = buf[(8 * I + i) * 68];
            for (int J = 0; J < I; ++J) {
                float xj[8];
#pragma unroll
                for (int j = 0; j < 8; ++j) xj[j] = buf[(8 * J + j) * 68];
#pragma unroll
                for (int i = 0; i < 8; ++i) { const f32x4 t0 = *(const LAS f32x4*)(tb + (8 * I + i) * 68 + 8 * J), t1 = *(const LAS f32x4*)(tb + (8 * I + i) * 68 + 8 * J + 4);
                    acc[i] -= t0.x * xj[0] + t0.y * xj[1] + t0.z * xj[2] + t0.w * xj[3] + t1.x * xj[4] + t1.y * xj[5] + t1.z * xj[6] + t1.w * xj[7]; }
            }
#pragma unroll
            for (int i = 1; i < 8; ++i) { const f32x4 t0 = *(const LAS f32x4*)(tb + (8 * I + i) * 68 + 8 * I), t1 = *(const LAS f32x4*)(tb + (8 * I + i) * 68 + 8 * I + 4);
                const float tv[8] = {t0.x, t0.y, t0.z, t0.w, t1.x, t1.y, t1.z, t1.w};
#pragma unroll
                for (int j = 0; j < i; ++j) acc[i] -= tv[j] * acc[j]; }
#pragma unroll
            for (int i = 0; i < 8; ++i) { buf[(8 * I + i) * 68] = acc[i]; *(LAS unsigned short*)(F.lds + DP_TB + (32 * blk + 8 * I + i) * DP_TP + 2 * (32 * blk + cc)) = (unsigned short)f2bf(acc[i]); }
        }
    } else { for (int idx = tid - 64; idx < 512; idx += NTHR - 64) { const int t = idx >> 3, s8 = (idx & 7) * 8; *(v4u*)(DA + (size_t)cidx * 4096 + t * 64 + s8) = *(const LAS v4u*)(F.lds + DP_AQL + t * DP_TP + 2 * s8); } }
    __syncthreads();
    { const int i = tid >> 4, j2 = (tid & 15) * 2;
      float m0_ = 0.f, m1_ = 0.f;
      for (int k = 0; k < 32; ++k) { const float l = tri[(32 + i) * 68 + k]; m0_ += l * tf[k * 68 + j2]; m1_ += l * tf[k * 68 + j2 + 1]; }
      tf[i * 68 + 32 + j2] = m0_; tf[i * 68 + 32 + j2 + 1] = m1_;
      *(LAS unsigned*)(F.lds + DP_TB + i * DP_TP + 2 * (32 + j2)) = 0u; }
    __syncthreads();
    { const int i = tid >> 4, j2 = (tid & 15) * 2;
      float a0 = 0.f, a1 = 0.f;
      for (int k = 0; k < 32; ++k) { const float t = tf[(32 + i) * 68 + 32 + k]; a0 += t * tf[k * 68 + 32 + j2]; a1 += t * tf[k * 68 + 32 + j2 + 1]; }
      *(LAS unsigned*)(F.lds + DP_TB + (32 + i) * DP_TP + 2 * j2) = pk2(-a0, -a1); }
    __syncthreads();
    { dp_b8 tfr[4][2];
#pragma unroll
      for (int mt = 0; mt < 4; ++mt)
#pragma unroll
          for (int ksp = 0; ksp < 2; ++ksp) tfr[mt][ksp] = __builtin_bit_cast(dp_b8, *(const LAS v4u*)(F.lds + DP_TB + (16 * mt + l15) * DP_TP + 64 * ksp + 16 * kq));
#pragma unroll
      for (int n2 = 0; n2 < 2; ++n2) { const int nt = 2 * wave + n2; const int col = 16 * nt + l15;
          dp_b8 bfr[2];
#pragma unroll
          for (int ksp = 0; ksp < 2; ++ksp) bfr[ksp] = __builtin_bit_cast(dp_b8, *(const LAS v4u*)(F.lds + DP_RT + col * DP_TP + 64 * ksp + 16 * kq));
          bf16* dst = (wave < 4 ? DU : DW) + (size_t)cidx * 8192 + ((16 * nt + 4 * kq) & 127);
#pragma unroll
          for (int mt = 0; mt < 4; ++mt) { pf4 acc = {0.f, 0.f, 0.f, 0.f};
#pragma unroll
              for (int ksp = 0; ksp < 2; ++ksp) acc = __builtin_amdgcn_mfma_f32_16x16x32_bf16(bfr[ksp], tfr[mt][ksp], acc, 0, 0, 0);
              *(uint2*)(dst + (16 * mt + l15) * 128) = make_uint2(pk2(acc[0], acc[1]), pk2(acc[2], acc[3])); } } }
    __syncthreads();
}

constexpr int DS_WROW = 288, DS_KROW = 160;
constexpr int DS_W = 0, DS_Q = 64 * DS_WROW, DS_K = 2 * 64 * DS_WROW, DS_A = DS_K + 128 * DS_KROW, DS_BUF = DS_A + 64 * DS_KROW;
typedef short dsb8 __attribute__((ext_vector_type(8)));
__device__ __forceinline__ dsb8 ds_afrag(const LAS unsigned char* p) { const v2u a = *(const LAS v2u*)p, b = *(const LAS v2u*)(p + 32); const v4u w = {a.x, a.y, b.x, b.y}; return __builtin_bit_cast(dsb8, w); }
__device__ __forceinline__ dsb8 ds_bfrag(const pf4 lo, const pf4 hi) { const v4u w = {pk2(lo[0], lo[1]), pk2(lo[2], lo[3]), pk2(hi[0], hi[1]), pk2(hi[2], hi[3])}; return __builtin_bit_cast(dsb8, w); }
struct DsSrc { const unsigned char* p[8]; };
#define DS_BAR() do { asm volatile("s_waitcnt lgkmcnt(0)" ::: "memory"); __builtin_amdgcn_s_barrier(); asm volatile("" ::: "memory"); } while (0)
__device__ __forceinline__ void dn_seq_unit(ARGREF A, Frame& F, bool samp, int b, int h, int e0) {
    const unsigned char* DW = (const unsigned char*)A.out; const unsigned char* DU = DW + (size_t)NCH * 4 * 64 * 128 * 2; const unsigned char* DQ = DU + (size_t)NCH * 4 * 64 * 128 * 2;
    const unsigned char* DK = (const unsigned char*)(A.ws + WS_DK); const unsigned char* DA = (const unsigned char*)(A.ws + WS_DA); const float* DEG = (const float*)(A.ws + WS_DEG);
    bf16* MIX = (bf16*)(A.ws + WS_MIXIN);
    const int lane = F.lane, wave = F.wave;
    const int nch = samp ? 1 : 128; const int cg0 = samp ? NCHP + b : b * 128;
    __syncthreads();
    if (wave != 0) {
        const int hl = (wave - 1) * 64 + lane;
        unsigned soff[8], doff[8];
        int kind[8];
#pragma unroll
        for (int k = 0; k < 8; ++k) { const int p = hl + 448 * k;
            if (p < 1024) { kind[k] = 0; soff[k] = p * 16; doff[k] = DS_W + (p >> 4) * DS_WROW + (p & 15) * 16; }
            else if (p < 2048) { const int q = p - 1024; kind[k] = 1; soff[k] = q * 16; doff[k] = DS_Q + (q >> 4) * DS_WROW + (q & 15) * 16; }
            else if (p < 3072) { const int q = p - 2048; kind[k] = 2; soff[k] = q * 16; doff[k] = DS_K + (q >> 3) * DS_KROW + (q & 7) * 16; }
            else { const int q = p - 3072; kind[k] = 3; soff[k] = q * 16; doff[k] = DS_A + (q >> 3) * DS_KROW + (q & 7) * 16; } }
        v4u R0[8], R1[8];
#define DS_LOAD(R, c) do { const size_t ci_ = (size_t)((cg0 + (c)) * 4 + h); _Pragma("unroll") for (int k = 0; k < 8; ++k) { \
            const unsigned char* src_ = kind[k] == 0 ? DW + ci_ * 16384 : kind[k] == 1 ? DQ + ci_ * 16384 : kind[k] == 2 ? DK + ci_ * 16384 : DA + ci_ * 8192; \
            R[k] = *(const v4u*)(src_ + soff[k]); } } while (0)
#define DS_PUT(R, bufi) do { _Pragma("unroll") for (int k = 0; k < 8; ++k) *(LAS v4u*)(F.lds + (bufi) * DS_BUF + doff[k]) = R[k]; } while (0)
        DS_LOAD(R0, 0); if (nch > 1) DS_LOAD(R1, 1);
        DS_PUT(R0, 0); if (nch > 2) DS_LOAD(R0, 2);
        DS_BAR();
        for (int c = 0; c < nch; c += 2) {
            if (c + 1 < nch) { DS_PUT(R1, 1); if (c + 3 < nch) DS_LOAD(R1, c + 3); }
            DS_BAR();
            if (c + 1 < nch) {
                if (c + 2 < nch) { DS_PUT(R0, 0); if (c + 4 < nch) DS_LOAD(R0, c + 4); }
                DS_BAR();
            }
        }
#undef DS_LOAD
#undef DS_PUT
    } else {
        const int fr = lane & 15, kq = lane >> 4;
        pf4 S[8];
#pragma unroll
        for (int i = 0; i < 8; ++i)
#pragma unroll
            for (int r = 0; r < 4; ++r) S[i][r] = samp ? A.in[IN_SD][(((size_t)b * 4 + h) * 128 + 16 * i + 4 * kq + r) * 128 + e0 + fr] : 0.f;
        unsigned short un[16], un2[16]; float eg1 = 0.f, eg2 = 0.f;
        { const unsigned short* up = (const unsigned short*)(DU + (size_t)(cg0 * 4 + h) * 16384) + e0 + fr;
#pragma unroll
          for (int q = 0; q < 16; ++q) un[q] = up[(16 * (q >> 2) + 4 * kq + (q & 3)) * 128];
          eg1 = DEG[cg0 * 4 + h];
          if (nch > 1) {
#pragma unroll
              for (int q = 0; q < 16; ++q) un2[q] = up[16384 * 2 + (16 * (q >> 2) + 4 * kq + (q & 3)) * 128];
              eg2 = DEG[cg0 * 4 + h + 4]; } }
        DS_BAR();
        for (int c = 0; c < nch; ++c) {
            const LAS unsigned char* B = F.lds + (c & 1) * DS_BUF;
            const int cidx = (cg0 + c) * 4 + h; const int m0 = chunk64_row0(cg0 + c);
            const float egl = eg1; eg1 = eg2;
            float uc[16];
#pragma unroll
            for (int q = 0; q < 16; ++q) { uc[q] = bf2f(un[q]); un[q] = un2[q]; }
            dsb8 Sb[4];
#pragma unroll
            for (int ks = 0; ks < 4; ++ks) Sb[ks] = ds_bfrag(S[2 * ks], S[2 * ks + 1]);
            pf4 ws[4], oo[4];
#pragma unroll
            for (int mt = 0; mt < 4; ++mt) { ws[mt] = (pf4){0.f, 0.f, 0.f, 0.f}; oo[mt] = (pf4){0.f, 0.f, 0.f, 0.f};
#pragma unroll
                for (int ks = 0; ks < 4; ++ks) {
                    ws[mt] = __builtin_amdgcn_mfma_f32_16x16x32_bf16(ds_afrag(B + DS_W + (16 * mt + fr) * DS_WROW + 64 * ks + 8 * kq), Sb[ks], ws[mt], 0, 0, 0);
                    oo[mt] = __builtin_amdgcn_mfma_f32_16x16x32_bf16(ds_afrag(B + DS_Q + (16 * mt + fr) * DS_WROW + 64 * ks + 8 * kq), Sb[ks], oo[mt], 0, 0, 0); } }
            pf4 dl[4];
#pragma unroll
            for (int mt = 0; mt < 4; ++mt)
#pragma unroll
                for (int r = 0; r < 4; ++r) dl[mt][r] = uc[4 * mt + r] - ws[mt][r];
            dsb8 Db[2];
#pragma unroll
            for (int ks = 0; ks < 2; ++ks) Db[ks] = ds_bfrag(dl[2 * ks], dl[2 * ks + 1]);
#pragma unroll
            for (int i = 0; i < 8; ++i) { S[i] = S[i] * egl;
#pragma unroll
                for (int ks = 0; ks < 2; ++ks) S[i] = __builtin_amdgcn_mfma_f32_16x16x32_bf16(ds_afrag(B + DS_K + (16 * i + fr) * DS_KROW + 64 * ks + 8 * kq), Db[ks], S[i], 0, 0, 0); }
#pragma unroll
            for (int mt = 0; mt < 4; ++mt) {
#pragma unroll
                for (int ks = 0; ks < 2; ++ks) oo[mt] = __builtin_amdgcn_mfma_f32_16x16x32_bf16(ds_afrag(B + DS_A + (16 * mt + fr) * DS_KROW + 64 * ks + 8 * kq), Db[ks], oo[mt], 0, 0, 0);
#pragma unroll
                for (int r = 0; r < 4; ++r) MIX[(size_t)(m0 + 16 * mt + 4 * kq + r) * DM + 512 + h * 128 + e0 + fr] = (bf16)f2bf(oo[mt][r]); }
            asm volatile("" ::: "memory");
            if (c + 2 < nch) { const unsigned short* up = (const unsigned short*)(DU + (size_t)(cidx + 8) * 16384) + e0 + fr;
#pragma unroll
                for (int q = 0; q < 16; ++q) un2[q] = up[(16 * (q >> 2) + 4 * kq + (q & 3)) * 128];
                eg2 = DEG[cidx + 8]; }
            LDS_WAIT();
            DS_BAR();
        }
        float* so = A.out + (samp ? O_SDS : O_SDP) + ((size_t)b * 4 + h) * 128 * 128;
#pragma unroll
        for (int i = 0; i < 8; ++i)
#pragma unroll
            for (int r = 0; r < 4; ++r) so[(16 * i + 4 * kq + r) * 128 + e0 + fr] = S[i][r];
    }
}
__device__ __forceinline__ void dn_out_norm(ARGREF A, Frame& F) {
    const bf16* ZD = (const bf16*)(A.ws + WS_ZD); bf16* MIX = (bf16*)(A.ws + WS_MIXIN);
    const int gw = F.bid * NWAVES + F.wave, NGW = F.G * NWAVES, lane = F.lane;
    float gn[8];
#pragma unroll
    for (int j = 0; j < 8; ++j) gn[j] = A.in[IN_DNORMG][8 * (lane & 15) + j];
    for (int m = 2 * gw; m < MT; m += 2 * NGW) {
        v4u ov[2], zv[2];
#pragma unroll
        for (int k = 0; k < 2; ++k) { ov[k] = *(const v4u*)(MIX + (size_t)(m + k) * DM + 512 + 8 * lane); zv[k] = *(const v4u*)(ZD + (size_t)(m + k) * 512 + 8 * lane); }
#pragma unroll
        for (int k = 0; k < 2; ++k) { float o[8], z[8]; unpack8(ov[k], o); unpack8(zv[k], z);
            float ss = 0.f;
#pragma unroll
            for (int j = 0; j < 8; ++j) ss += o[j] * o[j];
            ss = row16_sum(ss);
            const float rs = 1.0f / sqrtf(ss * (1.0f / 128.0f) + EPSN);
            pf4 a, c;
#pragma unroll
            for (int j = 0; j < 4; ++j) { a[j] = o[j] * rs * gn[j] * z[j]; c[j] = o[4 + j] * rs * gn[4 + j] * z[4 + j]; }
            *(v4u*)(MIX + (size_t)(m + k) * DM + 512 + 8 * lane) = pack8(a, c); } }
}
__device__ __forceinline__ void final_norm(ARGREF A, Frame& F, int row_lo, int row_hi, int gw, int NGW) {
    const float* SS = (const float*)(A.ws + WS_SSB); const float* fg = A.in[IN_FNORMG]; const bf16* H = (const bf16*)(A.ws + WS_HBA);
    const int lane = F.lane;
    float g[2][8];
#pragma unroll
    for (int q = 0; q < 2; ++q)
#pragma unroll
        for (int j = 0; j < 8; ++j) g[q][j] = fg[512 * q + 8 * lane + j];
    for (int m = row_lo + 2 * gw; m < row_hi; m += 2 * NGW) {
        v4u hv[2][2]; float s[2];
#pragma unroll
        for (int k = 0; k < 2; ++k) { const int mm = m + k; s[k] = (lane < 16) ? SS[(size_t)mm * 16 + lane] : 0.f;
#pragma unroll
            for (int q = 0; q < 2; ++q) hv[k][q] = *(const v4u*)(H + (size_t)mm * DM + 512 * q + 8 * lane); }
#pragma unroll
        for (int k = 0; k < 2; ++k) { const int mm = m + k; const float rs = 1.0f / sqrtf(wave_sum(s[k]) * (1.0f / DM) + EPSN);
            float* yr = (mm < MP ? A.out + O_YP + (size_t)mm * DM : A.out + O_YS + (size_t)(mm - MP) * DM) + 8 * lane;
#pragma unroll
            for (int q = 0; q < 2; ++q) { float h[8]; unpack8(hv[k][q], h);
                *(f32x4*)(yr + 512 * q) = (f32x4){h[0] * rs * g[q][0], h[1] * rs * g[q][1], h[2] * rs * g[q][2], h[3] * rs * g[q][3]};
                *(f32x4*)(yr + 512 * q + 4) = (f32x4){h[4] * rs * g[q][4], h[5] * rs * g[q][5], h[6] * rs * g[q][6], h[7] * rs * g[q][7]}; } } }
}
__global__ void __launch_bounds__(NTHR, 2) fwd(Args kernarg_unused) {
    CArgs* ap = (CArgs*)__builtin_amdgcn_kernarg_segment_ptr();
#define A (*ap)
#define RELOAD() asm volatile("" : "+s"(ap))
    extern __shared__ __attribute__((aligned(16))) unsigned char lds_raw[];
    Frame F;
    F.lds = (LAS unsigned char*)lds_raw;
    F.tid = threadIdx.x; F.lane = F.tid & 63; F.wave = __builtin_amdgcn_readfirstlane(F.tid >> 6);
    F.G = gridDim.x; F.bid = blockIdx.x; F.in = nullptr;
    for (int u = F.tid; u < (LDS_BYTES - LDSCTL_OFF) / 4; u += NTHR) ((LAS unsigned*)(F.lds + LDSCTL_OFF))[u] = 0u;
    __syncthreads();
    unsigned char* ws = ap->ws;
    XcdBarrier bar = xcd_barrier_post((unsigned*)ws + CW_BAR, (volatile LAS unsigned*)(F.lds + MISC_OFF) + 8, F.wave == 0);
#define GRID_BAR() do { xcd_barrier(bar, F.wave == 0); RELOAD(); { int t_ = fresh_tid(F.wave); asm volatile("" : "+v"(t_)); F.tid = t_; F.lane = t_ & 63; } } while (0)
    const int gw = F.bid * NWAVES + F.wave, NGW = F.G * NWAVES;
    bf16* HBA = (bf16*)(ws + WS_HBA); bf16* HBB = (bf16*)(ws + WS_HBB); bf16* MIX = (bf16*)(ws + WS_MIXIN); bf16* PPB = (bf16*)(ws + WS_PP);
    bf16* PB = (bf16*)(ws + WS_PB); bf16* P0 = (bf16*)(ws + WS_P0BUF); bf16* YB = (bf16*)(ws + WS_YB);
    float* SSA = (float*)(ws + WS_SSA); float* SSB = (float*)(ws + WS_SSB);

    p0_prologue(A, F);
    GRID_BAR();
    { pg8::Gemm g{HBA, (const bf16*)(ws + WS_W1T), MT, N1, DM, DM, DM}; pg8::StaticOrder S; S.init(MT, N1, F.G, F.bid);
      Epi1 E{P0, (const float*)(ws + WS_RSTD0)};
      pg8::gemm_phase<Epi1, pg8::StaticOrder, true, true>(F.lds, g, S, E, F.wave); }
    const int pp_r1 = (MT / 256) * (N1 / 256) % F.G, pp_n1 = pp_r1 ? (F.G - pp_r1) * 2 : 0;
    const int pp_r5 = (MT / 256) * 2 % F.G, pp_n5 = pp_r5 ? (F.G - pp_r5) : 0;
    if (pp_n1) { pg8::Gemm g{PB, (const bf16*)(ws + WS_WPLE0), MT, DM, 256, 256, 256}; pg8::StaticOrder S; S.init_range(MT, DM, F.G - pp_r1, F.bid >= pp_r1 ? F.bid - pp_r1 : (1 << 28), 0, pp_n1);
      EpiPlain E{PPB, DM};
      pg8::gemm_phase<EpiPlain, pg8::StaticOrder, true, true>(F.lds, g, S, E, F.wave); }
    GRID_BAR();
    for (int u = F.bid; u < 528 * 2; u += F.G) a_branch_unit(A, F, u >> 1, u & 1);
    { int t_ = fresh_tid(F.wave); asm volatile("" : "+v"(t_)); F.tid = t_; F.lane = t_ & 63; }
    for (int wu = gw; wu < 512 * 32; wu += NGW) s5_unit<1>(A, F, wu >> 5, wu & 31, (unsigned)(F.wave * S5_WLDS));
    GRID_BAR();
    s5_carry(A, F);
    GRID_BAR();
    for (int wu = gw; wu < 528 * 32; wu += NGW) s5_unit<2>(A, F, wu >> 5, wu & 31, (unsigned)(F.wave * S5_WLDS));
    GRID_BAR();
    { pg8::Gemm g{YB, (const bf16*)(ws + WS_WGLU), MT, 512, 512, 512, 512}; pg8::StaticOrder S; S.init(MT, 512, F.G, F.bid);
      EpiGlu E{YB, P0, MIX};
      pg8::gemm_phase<EpiGlu, pg8::StaticOrder, true, true>(F.lds, g, S, E, F.wave); }
    if (pp_n5) { pg8::Gemm g{PB, (const bf16*)(ws + WS_WPLE0), MT, DM, 256, 256, 256}; pg8::StaticOrder S; S.init_range(MT, DM, F.G - pp_r5, F.bid >= pp_r5 ? F.bid - pp_r5 : (1 << 28), pp_n1, pp_n1 + pp_n5);
      EpiPlain E{PPB, DM};
      pg8::gemm_phase<EpiPlain, pg8::StaticOrder, true, true>(F.lds, g, S, E, F.wave); }
    GRID_BAR();
    { pg8::Gemm g{MIX, (const bf16*)(ws + WS_WOUT0), MT, DM, DM, DM, DM}; pg8::StaticOrder S; S.init(MT, DM, F.G, F.bid);
      EpiRes<true> E{A.in[IN_XP], A.in[IN_XS], nullptr, HBB, SSA};
      pg8::gemm_phase<EpiRes<true>, pg8::StaticOrder, true, true>(F.lds, g, S, E, F.wave); }
    { pg8::Gemm g{PB, (const bf16*)(ws + WS_WPLE0), MT, DM, 256, 256, 256}; pg8::StaticOrder S; if (F.G >= 64) S.init_range(MT, DM, F.G - 16, F.bid >= 16 ? F.bid - 16 : (1 << 28), pp_n1 + pp_n5, 1 << 28); else S.init_range(MT, DM, F.G, F.bid, pp_n1 + pp_n5, 1 << 28);
      EpiPlain E{PPB, DM};
      pg8::gemm_phase<EpiPlain, pg8::StaticOrder, true, true>(F.lds, g, S, E, F.wave); }
    GRID_BAR();
    if (F.G >= 64 && MP / 256 * 4 % F.G == 0) {
        { pg8::Gemm g{HBB, (const bf16*)(ws + WS_WGATE0), MP, DM, DM, DM, DM}; pg8::StaticOrder S; S.init(MP, DM, F.G, F.bid);
          EpiGate<false> E{HBB, PPB, SSA, HBA, SSB, nullptr, nullptr};
          pg8::gemm_phase<EpiGate<false>, pg8::StaticOrder, true, true>(F.lds, g, S, E, F.wave); }
        GRID_BAR();
        unsigned* sgate = (unsigned*)ws + CW_SGATE;
        if (F.bid < 16) { { pg8::Gemm g{HBB + (size_t)MP * DM, (const bf16*)(ws + WS_WGATE0), MS, DM, DM, DM, DM}; pg8::StaticOrder S; S.init(MS, DM, 16, F.bid);
            EpiGate<false> E{HBB + (size_t)MP * DM, PPB + (size_t)MP * DM, SSA + (size_t)MP * 16, HBA + (size_t)MP * DM, SSB + (size_t)MP * 16, nullptr, nullptr};
            pg8::gemm_phase<EpiGate<false>, pg8::StaticOrder, true, true>(F.lds, g, S, E, F.wave); }
          asm volatile("s_waitcnt vmcnt(0)" ::: "memory"); __syncthreads();
          if (F.wave == 0 && __builtin_amdgcn_mbcnt_lo(~0u, 0u) == 0u) { __builtin_amdgcn_fence(__ATOMIC_RELEASE, "agent"); asm volatile("s_waitcnt vmcnt(0)" ::: "memory"); (void)xb_add(sgate, 1u); } }
        const int n8 = (MT / 256) * (N2 / 256), first8 = (n8 / F.G - 2) * F.G;
        { pg8::Gemm g{HBA, (const bf16*)(ws + WS_W2T), MT, N2, DM, DM, DM}; pg8::FlagOrder S; S.init_range(MT, N2, F.G, F.bid, 0, first8); S.flag = sgate; S.need = 16u; S.pm_wait = MP / 256;
          Epi2 E{SSB, (bf16*)(ws + WS_QZ), (bf16*)(ws + WS_QKVD), (bf16*)(ws + WS_ZD), (float*)(ws + WS_AB), A.out};
          pg8::gemm_phase<Epi2, pg8::FlagOrder, true, true>(F.lds, g, S, E, F.wave); }
        { pg8::Gemm g{HBA, (const bf16*)(ws + WS_W2T), MT, N2, DM, DM, DM}; pg8::FlagOrder S; S.init_range(MT, N2, F.G - 16, F.bid >= 16 ? F.bid - 16 : (1 << 28), first8, 1 << 28); S.flag = sgate; S.need = 16u; S.pm_wait = MP / 256;
          Epi2 E{SSB, (bf16*)(ws + WS_QZ), (bf16*)(ws + WS_QKVD), (bf16*)(ws + WS_ZD), (float*)(ws + WS_AB), A.out};
          pg8::gemm_phase<Epi2, pg8::FlagOrder, true, true>(F.lds, g, S, E, F.wave); }
    } else {
    { pg8::Gemm g{HBB, (const bf16*)(ws + WS_WGATE0), MT, DM, DM, DM, DM}; pg8::StaticOrder S; S.init(MT, DM, F.G, F.bid);
      EpiGate<false> E{HBB, PPB, SSA, HBA, SSB, nullptr, nullptr};
      pg8::gemm_phase<EpiGate<false>, pg8::StaticOrder, true, true>(F.lds, g, S, E, F.wave); }
    GRID_BAR();
    { pg8::Gemm g{HBA, (const bf16*)(ws + WS_W2T), MT, N2, DM, DM, DM}; pg8::StaticOrder S; S.init(MT, N2, F.G, F.bid);
      Epi2 E{SSB, (bf16*)(ws + WS_QZ), (bf16*)(ws + WS_QKVD), (bf16*)(ws + WS_ZD), (float*)(ws + WS_AB), A.out};
      pg8::gemm_phase<Epi2, pg8::StaticOrder, true, true>(F.lds, g, S, E, F.wave); }
    }
    GRID_BAR();
    for (int u = F.bid; u < NCH * 4; u += F.G) dn_prep_unit(A, F, u >> 2, u & 3);
    __syncthreads();
    for (int t = (F.G - 1 - F.bid) * NWAVES + F.wave; t < (MT / 32) * 8; t += NGW) attn_unit(A, F, t);
    GRID_BAR();
    for (int u = F.bid; u < 256 + 512; u += F.G) { const bool samp = u >= 256; const int v = samp ? u - 256 : u; const int xcd = v & 7, j = v >> 3; const int sl = j & 7, bh = (j >> 3) * 8 + xcd;
        dn_seq_unit(A, F, samp, bh >> 2, bh & 3, sl * 16); }
    GRID_BAR();
    dn_out_norm(A, F);
    GRID_BAR();
    { pg8::Gemm g{MIX, (const bf16*)(ws + WS_WOUT1), MT, DM, DM, DM, DM}; pg8::StaticOrder S; S.init(MT, DM, F.G, F.bid);
      EpiRes<false> E{nullptr, nullptr, HBA, HBB, SSA};
      pg8::gemm_phase<EpiRes<false>, pg8::StaticOrder, true, true>(F.lds, g, S, E, F.wave); }
    { pg8::Gemm g{PB + (size_t)MT * 256, (const bf16*)(ws + WS_WPLE1), MT, DM, 256, 256, 256}; pg8::StaticOrder S; if (F.G >= 64) S.init(MT, DM, F.G - 16, F.bid >= 16 ? F.bid - 16 : (1 << 28)); else S.init(MT, DM, F.G, F.bid);
      EpiPlain E{PPB, DM};
      pg8::gemm_phase<EpiPlain, pg8::StaticOrder, true, true>(F.lds, g, S, E, F.wave); }
    GRID_BAR();
    if (F.G >= 64) {
        { pg8::Gemm g{HBB, (const bf16*)(ws + WS_WGATE1), MP, DM, DM, DM, DM}; pg8::StaticOrder S; S.init(MP, DM, F.G, F.bid);
          EpiGate<false> E{HBB, PPB, SSA, HBA, SSB, nullptr, nullptr};
          pg8::gemm_phase<EpiGate<false>, pg8::StaticOrder, true, true>(F.lds, g, S, E, F.wave); }
        GRID_BAR();
        if (F.bid < 16) { pg8::Gemm g{HBB + (size_t)MP * DM, (const bf16*)(ws + WS_WGATE1), MS, DM, DM, DM, DM}; pg8::StaticOrder S; S.init(MS, DM, 16, F.bid);
          EpiGate<false> E{HBB + (size_t)MP * DM, PPB + (size_t)MP * DM, SSA + (size_t)MP * 16, HBA + (size_t)MP * DM, SSB + (size_t)MP * 16, nullptr, nullptr};
          pg8::gemm_phase<EpiGate<false>, pg8::StaticOrder, true, true>(F.lds, g, S, E, F.wave); }
        else final_norm(A, F, 0, MP, (F.bid - 16) * NWAVES + F.wave, (F.G - 16) * NWAVES);
        GRID_BAR();
        final_norm(A, F, MP, MT, gw, NGW);
    } else {
        { pg8::Gemm g{HBB, (const bf16*)(ws + WS_WGATE1), MT, DM, DM, DM, DM}; pg8::StaticOrder S; S.init(MT, DM, F.G, F.bid);
          EpiGate<false> E{HBB, PPB, SSA, HBA, SSB, nullptr, nullptr};
          pg8::gemm_phase<EpiGate<false>, pg8::StaticOrder, true, true>(F.lds, g, S, E, F.wave); }
        GRID_BAR();
        final_norm(A, F, 0, MT, gw, NGW);
    }
#undef A
}

extern "C" void kernel_launch(void* const* d_in, const int* in_sizes, int n_in, void* d_out, int out_size, void* d_ws, size_t ws_size, hipStream_t stream) {
    static int grid = 0;
    if (grid == 0) {
        if (n_in != 36 || (size_t)out_size != O_END || ws_size < WS_END) { fprintf(stderr, "kernel_launch: unexpected sizes n_in %d out %d ws %zu\n", n_in, out_size, ws_size); grid = -1; return; }
        int dev = 0, cus = 0, per_cu = 0;
        if (hipGetDevice(&dev) != hipSuccess || hipDeviceGetAttribute(&cus, hipDeviceAttributeMultiprocessorCount, dev) != hipSuccess) { grid = -1; return; }
        if (hipFuncSetAttribute((const void*)fwd, hipFuncAttributeMaxDynamicSharedMemorySize, LDS_BYTES) != hipSuccess) { grid = -1; return; }
        if (hipOccupancyMaxActiveBlocksPerMultiprocessor(&per_cu, (const void*)fwd, NTHR, LDS_BYTES) != hipSuccess || per_cu < 1) fprintf(stderr, "kernel_launch: occupancy query says %d\n", per_cu);
        (void)hipGetLastError();
        grid = cus > 0 ? cus : 256;
    }
    if (grid < 0) return;
    if (hipMemsetAsync((char*)d_ws + WS_CTL, 0, CTL_ZERO_BYTES, stream) != hipSuccess) return;
    Args a{};
    for (int i = 0; i < 36; ++i) a.in[i] = (const float*)d_in[i];
    a.out = (float*)d_out; a.ws = (unsigned char*)d_ws;
    hipLaunchKernelGGL(fwd, dim3(grid), dim3(NTHR), LDS_BYTES, stream, a);
}
```

```cpp
#include <hip/hip_runtime.h>
#include <cstdio>
#include <cstdint>
#define GAS __attribute__((address_space(1)))
#define LAS __attribute__((address_space(3)))
__device__ __forceinline__ int fresh_tid(int wave_s) { int w_ = wave_s << 6; asm volatile("" : "+s"(w_)); return (int)__builtin_amdgcn_mbcnt_hi(~0u, __builtin_amdgcn_mbcnt_lo(~0u, (unsigned)w_)); }
typedef GAS unsigned gu32;
namespace pg8 {
#define PG8_LAS __attribute__((address_space(3)))
typedef unsigned short bf16_t;
typedef short bf16x8 __attribute__((ext_vector_type(8)));
typedef float f32x4 __attribute__((ext_vector_type(4)));
typedef unsigned u32x4 __attribute__((ext_vector_type(4)));
constexpr int BM = 256, BK = 64, HALF = 128, HTB = HALF * BK * 2  , STAGE_BYTES = 8 * HTB, NXCD = 8, WGM = 8;

__host__ __device__ __forceinline__ int lds_byte(int r, int c) { const int st = (r >> 4) * 2 + (c >> 5), rr = r & 15, cc = c & 31, ob = rr * 64 + cc * 2; return st * 1024 + (ob ^ (((ob >> 9) & 1) << 5)); }
__host__ __device__ __forceinline__ void stage_rc(int b, int& R, int& C) { const int st = b / 1024, sb = b % 1024, swz = sb ^ (((sb >> 9) & 1) << 5); R = (st >> 1) * 16 + swz / 64; C = (st & 1) * 32 + (swz % 64) / 2; }
__host__ __device__ __forceinline__ int perm32(int rho) { const int n = rho >> 4, i = rho & 15; return 8 * (i >> 2) + 4 * n + (i & 3); }

struct Unit { int pm, pn; };
struct Gemm { const bf16_t* A; const bf16_t* Bt; int M, N, K, lda, ldb; };

struct StaticOrder {
    int nM, nN, nwg, G, c, lo, hi;
    __host__ __device__ void init(int M, int N, int G_, int c_) { nM = M / BM; nN = N / BM; nwg = nM * nN; G = G_; c = c_; lo = 0; hi = nwg; }
    __host__ __device__ void init_range(int M, int N, int G_, int c_, int lo_, int hi_) { init(M, N, G_, c_); lo = lo_ < nwg ? lo_ : nwg; hi = hi_ < nwg ? hi_ : nwg; }
    __host__ __device__ bool next(int i, Unit& u) const {
        const long L = (long)i * G + c + lo; if (L >= hi) return false;
        int wgid = (int)L; { const int q = nwg / NXCD, r = nwg % NXCD, xcd = wgid % NXCD, off = wgid / NXCD; wgid = (xcd < r ? xcd * (q + 1) : r * (q + 1) + (xcd - r) * q) + off; }
        const int nig = WGM * nN, gid = wgid / nig, fm = gid * WGM, gsz = (nM - fm) < WGM ? (nM - fm) : WGM;
        u.pm = fm + ((wgid % nig) % gsz); u.pn = (wgid % nig) / gsz; return true;
    }
    __device__ __forceinline__ void a_ready(const Unit&) const {}
    __device__ __forceinline__ void done(const Unit&) const {}
};
struct FlagOrder : StaticOrder {
    unsigned* flag; unsigned need; int pm_wait;
    __device__ __forceinline__ void a_ready(const Unit& u) const {
        if (u.pm >= pm_wait) { unsigned sp = 0;
            while (__hip_atomic_load(flag, __ATOMIC_RELAXED, __HIP_MEMORY_SCOPE_AGENT) < need) { __builtin_amdgcn_s_sleep(2); if (++sp > (1u << 22)) break; }
            __builtin_amdgcn_fence(__ATOMIC_ACQUIRE, "agent"); }
    }
};

__device__ __forceinline__ unsigned cvt_pk_bf16(float lo, float hi) { unsigned r; asm volatile("v_cvt_pk_bf16_f32 %0, %1, %2" : "=v"(r) : "v"(lo), "v"(hi)); return r; }
typedef float f32x2 __attribute__((ext_vector_type(2)));
template <class Epi, class Sched, bool ALIGN_EPI = false, bool SP2 = false>
__device__ __forceinline__ void gemm_phase(PG8_LAS unsigned char* lds, const Gemm g, const Sched& S, const Epi& E, const int wave_s) {
    int tid_l = fresh_tid(wave_s); asm volatile("" : "+v"(tid_l));
    const int tid = tid_l, wid = __builtin_amdgcn_readfirstlane(tid >> 6), lane = tid & 63, wr = wid >> 2, wc = wid & 3, fr = lane & 15, fq = lane >> 4;
    const int K = g.K, nt = K / BK;
    unsigned voffA[2], voffB[2];
#pragma unroll
    for (int i = 0; i < 2; ++i) { int R, C; stage_rc(tid * 16 + i * 8192, R, C); const int Rb = Epi::PERM ? ((R & ~31) + perm32(R & 31)) : R;
        voffA[i] = (unsigned)(R * g.lda + C) * 2u; voffB[i] = (unsigned)(Rb * g.ldb + C) * 2u; }
    const size_t kstep = (size_t)(BK * 2);
    const size_t hstepA = (size_t)HALF * g.lda * 2, hstepB = (size_t)HALF * g.ldb * 2;
    const size_t tstepA = 2 * hstepA, tstepB = 2 * hstepB;
    const unsigned ldsw = (unsigned)wid * 1024u;
    const int aoff = lds_byte(wr * 64 + fr, fq * 8), boff = lds_byte(wc * 32 + fr, fq * 8);
#define PG8_SA(b, h) (((b) * 2 + (h)) * HTB)
#define PG8_SB(b, h) ((4 + (b) * 2 + (h)) * HTB)
#define PG8_STAGE(bufoff, gbase, voff) do { _Pragma("unroll") for (int _i = 0; _i < 2; ++_i) { unsigned _vo = (voff)[_i]; asm volatile("" : "+v"(_vo));     \
        __builtin_amdgcn_global_load_lds((const unsigned*)((const char*)(gbase) + _vo), (PG8_LAS unsigned*)(lds + (bufoff) + ldsw + _i * 8192), 16, 0, 0); } } while (0)
#define PG8_LDA(dst, b, h) do { _Pragma("unroll") for (int m = 0; m < 4; ++m) _Pragma("unroll") for (int k = 0; k < 2; ++k) dst[m][k] = *(const PG8_LAS bf16x8*)(lds + PG8_SA(b, h) + aoff + m * 2048 + k * 1024); } while (0)
#define PG8_LDB(dst, b, h) do { _Pragma("unroll") for (int n = 0; n < 2; ++n) _Pragma("unroll") for (int k = 0; k < 2; ++k) dst[n][k] = *(const PG8_LAS bf16x8*)(lds + PG8_SB(b, h) + boff + n * 2048 + k * 1024); } while (0)
#define PG8_MMA(ai, bj, At, Bt) do { __builtin_amdgcn_s_setprio(1); _Pragma("unroll") for (int m = 0; m < 4; ++m) _Pragma("unroll") for (int n = 0; n < 2; ++n) _Pragma("unroll") for (int k = 0; k < 2; ++k) \
        acc[ai][bj][m][n] = __builtin_amdgcn_mfma_f32_16x16x32_bf16(Bt[n][k], At[m][k], acc[ai][bj][m][n], 0, 0, 0); __builtin_amdgcn_s_setprio(0); } while (0)
#define PG8_WAIT_V(n) asm volatile("s_waitcnt vmcnt(" #n ")" ::: "memory")
#define PG8_WAIT_L(n) asm volatile("s_waitcnt lgkmcnt(" #n ")" ::: "memory")
#define PG8_BAR __builtin_amdgcn_s_barrier()
#define PG8_SCHED __builtin_amdgcn_sched_barrier(0)
    Unit cur, nxt; int ui = 0;
    if (!S.next(0, cur)) return;
    f32x4 acc[2][2][4][2];
#pragma unroll
    for (int a = 0; a < 2; ++a)
#pragma unroll
        for (int b = 0; b < 2; ++b)
#pragma unroll
            for (int m = 0; m < 4; ++m)
#pragma unroll
                for (int n = 0; n < 2; ++n) acc[a][b][m][n] = (f32x4){0.f, 0.f, 0.f, 0.f};
    bf16x8 At[4][2], B0[2][2], B1[2][2];
    const char* cA = (const char*)g.A + (size_t)cur.pm * tstepA; const char* cB = (const char*)g.Bt + (size_t)cur.pn * tstepB;
    S.a_ready(cur);
    if constexpr (SP2) {
        PG8_STAGE(PG8_SB(0, 0), cB, voffB); PG8_STAGE(PG8_SB(0, 1), cB + hstepB, voffB); PG8_STAGE(PG8_SA(0, 0), cA, voffA); PG8_STAGE(PG8_SA(0, 1), cA + hstepA, voffA);
        if (wr == 1) PG8_BAR;
        PG8_WAIT_V(2); PG8_BAR;
        PG8_STAGE(PG8_SB(1, 0), cB + kstep, voffB); PG8_STAGE(PG8_SA(1, 0), cA + kstep, voffA); PG8_STAGE(PG8_SB(1, 1), cB + hstepB + kstep, voffB);
        PG8_WAIT_V(6); PG8_BAR;
    } else {
        PG8_STAGE(PG8_SB(0, 0), cB, voffB); PG8_STAGE(PG8_SA(0, 0), cA, voffA); PG8_STAGE(PG8_SB(0, 1), cB + hstepB, voffB); PG8_STAGE(PG8_SA(0, 1), cA + hstepA, voffA);
        if (wr == 1) PG8_BAR;
        PG8_WAIT_V(4); PG8_BAR;
        PG8_STAGE(PG8_SB(1, 0), cB + kstep, voffB); PG8_STAGE(PG8_SA(1, 0), cA + kstep, voffA); PG8_STAGE(PG8_SB(1, 1), cB + hstepB + kstep, voffB);
        PG8_WAIT_V(6); PG8_BAR;
    }
    for (;;) {
        const bool has_next = S.next(ui + 1, nxt);
        const char* nA = has_next ? (const char*)g.A + (size_t)nxt.pm * tstepA : cA; const char* nB = has_next ? (const char*)g.Bt + (size_t)nxt.pn * tstepB : cB;
        for (int t = 0; t < nt; t += 2) {
            const bool last = (t == nt - 2);
            const char* a1 = cA + (size_t)(t + 1) * kstep;
            const char* a2 = last ? nA : cA + (size_t)(t + 2) * kstep; const char* b2 = last ? nB : cB + (size_t)(t + 2) * kstep;
            const char* a3 = a2 + kstep; const char* b3 = b2 + kstep;
            if (last && has_next) S.a_ready(nxt);
            if constexpr (SP2) {
            PG8_LDB(B0, 0, 0); PG8_LDB(B1, 0, 1); PG8_SCHED; PG8_LDA(At, 0, 0); PG8_STAGE(PG8_SA(1, 1), a1 + hstepA, voffA);
            PG8_WAIT_V(8); PG8_WAIT_L(0); PG8_BAR; PG8_MMA(0, 0, At, B0); PG8_MMA(0, 1, At, B1); PG8_BAR; PG8_SCHED;
            PG8_LDA(At, 0, 1); PG8_STAGE(PG8_SB(0, 0), b2, voffB); PG8_STAGE(PG8_SB(0, 1), b2 + hstepB, voffB); PG8_STAGE(PG8_SA(0, 0), a2, voffA);
            PG8_WAIT_V(8); PG8_WAIT_L(0); PG8_BAR; PG8_MMA(1, 0, At, B0); PG8_MMA(1, 1, At, B1); PG8_BAR; PG8_SCHED;
            PG8_LDB(B0, 1, 0); PG8_LDB(B1, 1, 1); PG8_SCHED; PG8_LDA(At, 1, 0); PG8_STAGE(PG8_SA(0, 1), a2 + hstepA, voffA);
            PG8_WAIT_V(8); PG8_WAIT_L(0); PG8_BAR; PG8_MMA(0, 0, At, B0); PG8_MMA(0, 1, At, B1); PG8_BAR; PG8_SCHED;
            PG8_LDA(At, 1, 1); PG8_STAGE(PG8_SB(1, 0), b3, voffB); PG8_STAGE(PG8_SB(1, 1), b3 + hstepB, voffB); PG8_STAGE(PG8_SA(1, 0), a3, voffA);
            PG8_WAIT_V(8); PG8_WAIT_L(0); PG8_BAR; PG8_MMA(1, 0, At, B0); PG8_MMA(1, 1, At, B1); PG8_BAR; PG8_SCHED;
            } else {
            PG8_LDB(B0, 0, 0); PG8_SCHED; PG8_LDA(At, 0, 0); PG8_STAGE(PG8_SA(1, 1), a1 + hstepA, voffA);
            PG8_WAIT_L(8); PG8_BAR; PG8_WAIT_L(0); PG8_MMA(0, 0, At, B0); PG8_BAR; PG8_SCHED;
            PG8_LDB(B1, 0, 1); PG8_STAGE(PG8_SB(0, 0), b2, voffB);
            PG8_BAR; PG8_WAIT_L(0); PG8_MMA(0, 1, At, B1); PG8_BAR;
            PG8_LDA(At, 0, 1); PG8_STAGE(PG8_SA(0, 0), a2, voffA);
            PG8_BAR; PG8_WAIT_L(0); PG8_MMA(1, 0, At, B0); PG8_BAR; PG8_SCHED;
            PG8_STAGE(PG8_SB(0, 1), b2 + hstepB, voffB);
            PG8_WAIT_V(6); PG8_BAR; PG8_MMA(1, 1, At, B1); PG8_BAR;
            PG8_LDB(B0, 1, 0); PG8_SCHED; PG8_LDA(At, 1, 0); PG8_STAGE(PG8_SA(0, 1), a2 + hstepA, voffA);
            PG8_WAIT_L(8); PG8_BAR; PG8_WAIT_L(0); PG8_MMA(0, 0, At, B0); PG8_BAR; PG8_SCHED;
            PG8_LDB(B1, 1, 1); PG8_STAGE(PG8_SB(1, 0), b3, voffB);
            PG8_BAR; PG8_WAIT_L(0); PG8_MMA(0, 1, At, B1); PG8_BAR;
            PG8_LDA(At, 1, 1); PG8_STAGE(PG8_SA(1, 0), a3, voffA);
            PG8_BAR; PG8_WAIT_L(0); PG8_MMA(1, 0, At, B0); PG8_BAR; PG8_SCHED;
            PG8_STAGE(PG8_SB(1, 1), b3 + hstepB, voffB);
            PG8_WAIT_V(6); PG8_BAR; PG8_MMA(1, 1, At, B1); PG8_BAR;
            }
        }
        if constexpr (ALIGN_EPI) { if (wr == 0) PG8_BAR; }
        if constexpr (!Epi::AFTER_DRAIN) { E(acc, cur, wr, wc, fr, fq); S.done(cur); }
        if (!has_next) break;
#pragma unroll
        for (int a = 0; a < 2; ++a)
#pragma unroll
            for (int b = 0; b < 2; ++b)
#pragma unroll
                for (int m = 0; m < 4; ++m)
#pragma unroll
                    for (int n = 0; n < 2; ++n) acc[a][b][m][n] = (f32x4){0.f, 0.f, 0.f, 0.f};
        cur = nxt; cA = nA; cB = nB; ++ui;
        if constexpr (ALIGN_EPI) { if (wr == 1) PG8_BAR; }
    }
    PG8_WAIT_V(0);
    if constexpr (!ALIGN_EPI) { if (wr == 0) PG8_BAR; }
    PG8_BAR;
    if constexpr (Epi::AFTER_DRAIN) { E.fused(acc, cur, wr, wc, fr, fq, lds, wid, lane); S.done(cur); }
#undef PG8_SA
#undef PG8_SB
#undef PG8_STAGE
#undef PG8_LDA
#undef PG8_LDB
#undef PG8_MMA
#undef PG8_WAIT_V
#undef PG8_WAIT_L
#undef PG8_BAR
#undef PG8_SCHED
}
}
#define XB_TMO      128
#define XB_XCNT(j)  (256  + 64 * (j))
#define XB_XSUB(j)  (1280 + 64 * (j))
#define XB_XGEN(j)  (2304 + 64 * (j))
#define XB_TOP      3328
#define XB_TOPGEN   3392
#define XCD_BAR_WORDS 3456
#define XB_SPIN_CAP (1u << 23)

__device__ __forceinline__ unsigned xb_ld(unsigned* p)              { return __hip_atomic_load(p, __ATOMIC_RELAXED, __HIP_MEMORY_SCOPE_AGENT); }
__device__ __forceinline__ unsigned xb_add(unsigned* p, unsigned v) { return __hip_atomic_fetch_add(p, v, __ATOMIC_RELAXED, __HIP_MEMORY_SCOPE_AGENT); }
__device__ __forceinline__ unsigned xb_xcc_id() { return (unsigned)__builtin_amdgcn_s_getreg((3 << 11) | 20) & 0xFu; }
#define XB_SPIN(cond, bar) do { unsigned _sp = 0; while (cond) { __builtin_amdgcn_s_sleep(1); \
    if ((++_sp & 255u) == 0u) { if (xb_ld(&(bar)[XB_TMO])) break; if (_sp > XB_SPIN_CAP) { atomicAdd(&(bar)[XB_TMO], 1u); break; } } } } while (0)

struct XcdBarrier {
    unsigned* bar; unsigned x;
    volatile LAS unsigned* st;
};

__device__ __forceinline__ XcdBarrier xcd_barrier_post(unsigned* bar, volatile LAS unsigned* st, const bool leader_wave) {
    XcdBarrier b; b.bar = bar; b.x = xb_xcc_id(); b.st = st;
    if (leader_wave && __builtin_amdgcn_mbcnt_lo(~0u, 0u) == 0u) (void)xb_add(&bar[XB_XCNT(b.x)], 1u);
    return b;
}
__device__ __forceinline__ void xcd_barrier_complete(unsigned* bar, unsigned x, unsigned& nloc, unsigned& nx) {
    const unsigned G = gridDim.x * gridDim.y * gridDim.z;
    unsigned sum, cnt, mine, sp = 0u;
    for (;;) {
        sum = 0u; cnt = 0u; mine = 0u;
#pragma unroll
        for (unsigned j = 0; j < 16; ++j) { const unsigned c = xb_ld(&bar[XB_XCNT(j)]); sum += c; cnt += (c > 0u) ? 1u : 0u; mine = (j == x) ? c : mine; }
        if (sum == G) break;
        __builtin_amdgcn_s_sleep(1);
        if ((++sp & 255u) == 0u) { if (xb_ld(&bar[XB_TMO])) break; if (sp > XB_SPIN_CAP) { atomicAdd(&bar[XB_TMO], 1u); break; } }
    }
    nloc = mine > 0u ? mine : 1u; nx = cnt > 0u ? cnt : 1u;
}

__device__ __forceinline__ void xcd_barrier(const XcdBarrier& b, const bool leader_wave) {
    asm volatile("s_waitcnt vmcnt(0)" ::: "memory");
    __syncthreads();
    if (leader_wave && __builtin_amdgcn_mbcnt_lo(~0u, 0u) == 0u) {
        unsigned* bar = b.bar;
        __builtin_amdgcn_s_waitcnt(0);
        unsigned nloc = b.st[0], nx = b.st[1];
        if (nloc == 0u) { xcd_barrier_complete(bar, b.x, nloc, nx); b.st[0] = nloc; b.st[1] = nx; }
        const unsigned old = xb_add(&bar[XB_XSUB(b.x)], 1u);
        const unsigned gen = old / nloc;
        if (old + 1u == (gen + 1u) * nloc) {
            __builtin_amdgcn_fence(__ATOMIC_RELEASE, "agent");
            asm volatile("s_waitcnt vmcnt(0)" ::: "memory");
            const unsigned og = xb_add(&bar[XB_TOP], 1u);
            const unsigned tg = og / nx;
            if (og + 1u == (tg + 1u) * nx) xb_add(&bar[XB_TOPGEN], 1u);
            else XB_SPIN(xb_ld(&bar[XB_TOPGEN]) == tg, bar);
            __builtin_amdgcn_fence(__ATOMIC_ACQUIRE, "agent");
            xb_add(&bar[XB_XGEN(b.x)], 1u);
            asm volatile("s_waitcnt vmcnt(0)" ::: "memory");
        } else {
            XB_SPIN(xb_ld(&bar[XB_XGEN(b.x)]) == gen, bar);
            __builtin_amdgcn_fence(__ATOMIC_ACQUIRE, "agent");
            asm volatile("s_waitcnt vmcnt(0)" ::: "memory");
        }
    }
    __syncthreads();
}
constexpr int NWAVES = 8, NTHR = 512;
constexpr int DM = 1024, MP = 65536, MS = 1024, MT = 66560;
constexpr int LP = 8192, LS = 64, NBP = 8, NBS = 16, PAST = 4096;
constexpr float EPSN = 1e-6f;
constexpr int N1 = 2560, N2 = 4352, ODD_IN = 4104;
constexpr int NCHP = 1024, NCH = 1040;
constexpr size_t O_YP = 0, O_YS = O_YP + (size_t)MP * DM, O_BREP = O_YS + (size_t)MS * DM, O_BIMP = O_BREP + 8 * 32 * 64,
    O_KCP = O_BIMP + 8 * 32 * 64, O_VCP = O_KCP + (size_t)MP * 512, O_SDP = O_VCP + (size_t)MP * 512, O_CONVP = O_SDP + 8 * 4 * 128 * 128,
    O_BRES = O_CONVP + 8 * 3 * 1536, O_BIMS = O_BRES + 16 * 32 * 64, O_AVS = O_BIMS + 16 * 32 * 64, O_KCS = O_AVS + (size_t)MS * 512,
    O_VCS = O_KCS + (size_t)MS * 512, O_SDS = O_VCS + (size_t)MS * 512, O_CONVS = O_SDS + 16 * 4 * 128 * 128, O_END = O_CONVS + 16 * 3 * 1536;
static_assert(O_END == 138620928ull, "output size");
constexpr size_t MiB = 1u << 20;
constexpr size_t WS_CTL = 0, CTL_ZERO_BYTES = 1 * MiB;
constexpr size_t WS_W1T = 1 * MiB, WS_WGLU = 7 * MiB, WS_WOUT0 = 8 * MiB, WS_WGATE0 = 10 * MiB, WS_WGATE1 = 12 * MiB, WS_WPLE0 = 14 * MiB, WS_WPLE1 = 15 * MiB,
    WS_W2T = 16 * MiB, WS_WOUT1 = 25 * MiB;
constexpr size_t WS_RSTD0 = 27 * MiB, WS_SSA = 28 * MiB, WS_SSB = 33 * MiB, WS_AB = 38 * MiB, WS_S5TAB = 41 * MiB, WS_S5E = 42 * MiB, WS_S5C = 50 * MiB, WS_DEG = 58 * MiB;
constexpr size_t WS_HBA = 64 * MiB, WS_MIXIN = 194 * MiB, WS_HBB = 324 * MiB, WS_PP = 454 * MiB, WS_PB = 584 * MiB, WS_R6 = 649 * MiB, WS_END = 1024 * MiB;
constexpr size_t WS_P0BUF = WS_R6, WS_YB = WS_R6 + 260 * MiB;
constexpr size_t WS_QZ = WS_R6, WS_DK = WS_R6 + 260 * MiB, WS_OD = WS_R6 + 325 * MiB;
constexpr size_t WS_QKVD = WS_HBB, WS_ZD = WS_HBB + 195 * MiB;
constexpr size_t WS_DA = WS_PB;
static_assert(WS_ZD + 65 * MiB == WS_PB && WS_OD <= WS_END, "ws map");
constexpr size_t WS_AWB = WS_S5TAB + 512 * 1024;
constexpr int T_AR = 0, T_AI = 2048, T_PR = 4096, T_PI = 6144, T_BBR = 8192, T_BBI = T_BBR + 32768;
constexpr int CW_BAR = 4096, CW_ATTN = 8192, CW_SGATE = 8256;
constexpr int LDS_BYTES = 147456, RING_BYTES = 131072, LDSCTL_OFF = LDS_BYTES - 1024, MISC_OFF = LDSCTL_OFF + 320;

typedef unsigned short bf16;
typedef unsigned v4u __attribute__((ext_vector_type(4)));
typedef unsigned v2u __attribute__((ext_vector_type(2)));
typedef float f32x4 __attribute__((ext_vector_type(4)));
typedef float f32x16 __attribute__((ext_vector_type(16)));
#define LDS_WAIT() asm volatile("s_waitcnt lgkmcnt(0)" ::: "memory")
#define VM_WAIT() asm volatile("s_waitcnt vmcnt(0)" ::: "memory")

__device__ __forceinline__ float bf2f(unsigned b) { return __uint_as_float(b << 16); }
typedef __bf16 bf2_t __attribute__((ext_vector_type(2)));
typedef float f2_t __attribute__((ext_vector_type(2)));
__device__ __forceinline__ unsigned pk2(float lo, float hi) { const f2_t v = {lo, hi}; const bf2_t b = __builtin_convertvector(v, bf2_t); return __builtin_bit_cast(unsigned, b); }
__device__ __forceinline__ unsigned f2bf(float f) { return pk2(f, f) & 0xffffu; }
__device__ __forceinline__ float bflo(unsigned w) { return __uint_as_float(w << 16); }
__device__ __forceinline__ float bfhi(unsigned w) { return __uint_as_float(w & 0xffff0000u); }
__device__ __forceinline__ float fsigmoid(float x) { return __builtin_amdgcn_rcpf(1.0f + __builtin_amdgcn_exp2f(x * -1.4426950408889634f)); }
__device__ __forceinline__ float fsig2(float x2) { return __builtin_amdgcn_rcpf(1.0f + __builtin_amdgcn_exp2f(x2)); }
__device__ __forceinline__ float fsilu(float x) { return x * fsigmoid(x); }
__device__ __forceinline__ float fgelu(float x) { const float x2 = x * x; return x * fsig2(x * (-2.302208198f - 0.1029432397f * x2)); }
__device__ __forceinline__ float fsoftplus(float x) { return fmaxf(x, 0.0f) + log1pf(__expf(-fabsf(x))); }
__device__ __forceinline__ float dpp_f(float v, const int ctrl_tag) {
    int r;
    if (ctrl_tag == 0) r = __builtin_amdgcn_update_dpp(0, __float_as_int(v), 0xB1, 0xf, 0xf, false);
    else if (ctrl_tag == 1) r = __builtin_amdgcn_update_dpp(0, __float_as_int(v), 0x4E, 0xf, 0xf, false);
    else if (ctrl_tag == 2) r = __builtin_amdgcn_update_dpp(0, __float_as_int(v), 0x141, 0xf, 0xf, false);
    else r = __builtin_amdgcn_update_dpp(0, __float_as_int(v), 0x140, 0xf, 0xf, false);
    return __int_as_float(r);
}
__device__ __forceinline__ float row16_sum(float v) { v += dpp_f(v, 0); v += dpp_f(v, 1); v += dpp_f(v, 2); v += dpp_f(v, 3); return v; }
typedef unsigned u2_t __attribute__((ext_vector_type(2)));
__device__ __forceinline__ float xor32f(float x) { const u2_t r = __builtin_amdgcn_permlane32_swap(__float_as_uint(x), __float_as_uint(x), false, false); return __uint_as_float(__builtin_amdgcn_inverse_ballot_w64(0xFFFFFFFF00000000ull) ? r.x : r.y); }
__device__ __forceinline__ float xor16f(float x) { const u2_t r = __builtin_amdgcn_permlane16_swap(__float_as_uint(x), __float_as_uint(x), false, false); return __uint_as_float(__builtin_amdgcn_inverse_ballot_w64(0xFFFF0000FFFF0000ull) ? r.x : r.y); }
__device__ __forceinline__ float wave_sum(float v) { v = row16_sum(v); v += xor16f(v); v += xor32f(v); return v; }
__device__ __forceinline__ const float* xrow_ptr(const float* xp, const float* xs, int m) { return m < MP ? xp + (size_t)m * DM : xs + (size_t)(m - MP) * DM; }
struct Args { const float* in[36]; float* out; unsigned char* ws; };
typedef const __attribute__((address_space(4))) Args CArgs;
#define ARGREF CArgs&
struct Frame {
    LAS unsigned char* lds;
    int tid, lane, wave, G, bid;
    const float* const* in;
};
#define IN_XP 0
#define IN_XS 1
#define IN_SBRE 2
#define IN_SBIM 3
#define IN_CK 4
#define IN_CV 5
#define IN_SD 6
#define IN_SCONV 7
#define IN_PP 8
#define IN_PS 9
#define IN_NORMG 10
#define IN_FNORMG 11
#define IN_PLEPROJ 12
#define IN_PLEGATE 13
#define IN_PLENORM 14
#define IN_EWIN 15
#define IN_EWOUT 16
#define IN_ALNG 17
#define IN_ALNB 18
#define IN_AWS 19
#define IN_ABS 20
#define IN_LAMRE 21
#define IN_LAMIM 22
#define IN_LOGDT 23
#define IN_BRE 24
#define IN_BIM 25
#define IN_CRE 26
#define IN_CIM 27
#define IN_BD 28
#define IN_GLUW 29
#define IN_OWIN 30
#define IN_OWOUT 31
#define IN_CONVW 32
#define IN_ALOG 33
#define IN_DTB 34
#define IN_DNORMG 35

__device__ __forceinline__ void p0_transpose_item(const float* W, int ldw, int K, int ncols_src, int scol0, bf16* WT, int n0, int k0, const float* kscale, LAS float* scr, int lane) {
    { float wv[32]; const int sc = scol0 + (lane & 31);
#pragma unroll
      for (int i = 0; i < 32; ++i) { const int kk = 2 * i + (lane >> 5); wv[i] = (sc < ncols_src) ? W[(size_t)(k0 + kk) * ldw + sc] : 0.0f; }
#pragma unroll
      for (int i = 0; i < 32; ++i) { const int kk = 2 * i + (lane >> 5); float v = wv[i]; if (kscale) v *= kscale[k0 + kk]; scr[kk * 33 + (lane & 31)] = v; } }
    LDS_WAIT(); asm volatile("" ::: "memory");
    const int c = lane & 7;
#pragma unroll
    for (int j = 0; j < 4; ++j) { const int n = (lane >> 3) + 8 * j; const LAS float* s = scr + (8 * c) * 33 + n;
        v4u o; o.x = pk2(s[0 * 33], s[1 * 33]); o.y = pk2(s[2 * 33], s[3 * 33]); o.z = pk2(s[4 * 33], s[5 * 33]); o.w = pk2(s[6 * 33], s[7 * 33]);
        *(v4u*)(WT + (size_t)(n0 + n) * K + k0 + 8 * c) = o; }
    LDS_WAIT(); asm volatile("" ::: "memory");
}
__device__ __forceinline__ void p0_transpose_mat(const float* W, int ldw, int K, int ncols_src, int Ndst, bf16* WT, const float* kscale, LAS float* scr, int& gwo, int NGW, int lane) {
    const int nblk = Ndst / 32, nitems = (K / 64) * nblk;
    int it = gwo;
    for (; it < nitems; it += NGW) { const int kb = it / nblk, nb = it % nblk; p0_transpose_item(W, ldw, K, ncols_src, 32 * nb, WT, 32 * nb, 64 * kb, kscale, scr, lane); }
    gwo = it - nitems;
}
__device__ __forceinline__ int w1_srccol(int n0) {
    const int j = n0 >> 8, c = n0 & 255;
    if (j < 4) return c < 128 ? 128 * j + c : 1024 + 128 * j + (c - 128);
    if (j < 6) return 512 + 256 * (j - 4) + c;
    if (j < 8) return 1536 + 256 * (j - 6) + c;
    return 2048 + 256 * (j - 8) + c;
}
__device__ __forceinline__ void p0_prologue(ARGREF A, Frame& F) {
    unsigned char* ws = A.ws;
    LAS float* scr = (LAS float*)(F.lds + F.wave * 16384);
    const int gw = F.bid * NWAVES + F.wave, NGW = F.G * NWAVES, lane = F.lane;
    int gwo = gw;
    { const int nblk = N1 / 32, nitems = (DM / 64) * nblk; int it = gwo;
      for (; it < nitems; it += NGW) { const int kb = it / nblk, nb = it % nblk; p0_transpose_item(A.in[IN_EWIN], N1, DM, N1, w1_srccol(32 * nb), (bf16*)(ws + WS_W1T), 32 * nb, 64 * kb, A.in[IN_NORMG], scr, lane); }
      gwo = it - nitems; }
    p0_transpose_mat(A.in[IN_GLUW], 512, 512, 512, 512, (bf16*)(ws + WS_WGLU), nullptr, scr, gwo, NGW, lane);
    p0_transpose_mat(A.in[IN_EWOUT], DM, DM, DM, DM, (bf16*)(ws + WS_WOUT0), nullptr, scr, gwo, NGW, lane);
    p0_transpose_mat(A.in[IN_PLEGATE], DM, DM, DM, DM, (bf16*)(ws + WS_WGATE0), A.in[IN_PLENORM], scr, gwo, NGW, lane);
    p0_transpose_mat(A.in[IN_PLEGATE] + (size_t)DM * DM, DM, DM, DM, DM, (bf16*)(ws + WS_WGATE1), A.in[IN_PLENORM] + DM, scr, gwo, NGW, lane);
    p0_transpose_mat(A.in[IN_PLEPROJ], DM, 256, DM, DM, (bf16*)(ws + WS_WPLE0), nullptr, scr, gwo, NGW, lane);
    p0_transpose_mat(A.in[IN_PLEPROJ] + (size_t)256 * DM, DM, 256, DM, DM, (bf16*)(ws + WS_WPLE1), nullptr, scr, gwo, NGW, lane);
    p0_transpose_mat(A.in[IN_OWIN], ODD_IN, DM, ODD_IN, N2, (bf16*)(ws + WS_W2T), A.in[IN_NORMG] + DM, scr, gwo, NGW, lane);
    p0_transpose_mat(A.in[IN_OWOUT], DM, DM, DM, DM, (bf16*)(ws + WS_WOUT1), nullptr, scr, gwo, NGW, lane);
    { bf16* XB = (bf16*)(ws + WS_HBA); float* RS = (float*)(ws + WS_RSTD0);
      for (int m = 2 * gw; m < MT; m += 2 * NGW) {
        f32x4 v[2][4];
#pragma unroll
        for (int k = 0; k < 2; ++k) { const f32x4* xr = (const f32x4*)xrow_ptr(A.in[IN_XP], A.in[IN_XS], m + k) + lane;
#pragma unroll
            for (int j = 0; j < 4; ++j) v[k][j] = xr[64 * j]; }
#pragma unroll
        for (int k = 0; k < 2; ++k) { float s = 0.f;
#pragma unroll
            for (int j = 0; j < 4; ++j) s += (v[k][j].x * v[k][j].x + v[k][j].y * v[k][j].y) + (v[k][j].z * v[k][j].z + v[k][j].w * v[k][j].w);
            s = wave_sum(s);
            v2u* o8 = (v2u*)(XB + (size_t)(m + k) * DM) + lane;
#pragma unroll
            for (int j = 0; j < 4; ++j) { v2u w; w.x = pk2(v[k][j].x, v[k][j].y); w.y = pk2(v[k][j].z, v[k][j].w); o8[64 * j] = w; }
            if (lane == 0) RS[m + k] = 1.0f / sqrtf(s * (1.0f / DM) + EPSN); }
      } }
    { bf16* PB = (bf16*)(ws + WS_PB); const unsigned gt = (unsigned)(F.bid * NTHR + F.tid), gs = (unsigned)(F.G * NTHR);
#pragma unroll
      for (int seg = 0; seg < 4; ++seg) { const int i = seg >> 1; const bool smp = seg & 1;
          const f32x4* src = (const f32x4*)(smp ? A.in[IN_PS] + (size_t)i * MS * 256 : A.in[IN_PP] + (size_t)i * MP * 256);
          v2u* dst = (v2u*)(PB + ((size_t)i * MT + (smp ? MP : 0)) * 256);
          const unsigned n4 = (unsigned)((smp ? MS : MP) * 64);
          for (unsigned q0 = gt; q0 < n4; q0 += 8 * gs) { f32x4 v[8];
#pragma unroll
              for (int k = 0; k < 8; ++k) { const unsigned q = q0 + k * gs; if (q < n4) v[k] = src[q]; }
#pragma unroll
              for (int k = 0; k < 8; ++k) { const unsigned q = q0 + k * gs; if (q < n4) { v2u w; w.x = pk2(v[k].x, v[k].y); w.y = pk2(v[k].z, v[k].w); dst[q] = w; } } } } }
    { bf16* WB = (bf16*)(ws + WS_AWB); const int gt = F.bid * NTHR + F.tid, gs_ = F.G * NTHR;
      for (int q = gt; q < 4 * 128 * 128 / 2; q += gs_) { const int e = 2 * q, t = (e >> 7) & 127, s = e & 127; const float a = A.in[IN_AWS][e], b = A.in[IN_AWS][e + 1];
        *(unsigned*)(WB + e) = pk2(s <= t ? a : 0.f, s + 1 <= t ? b : 0.f); } }
    { float* T = (float*)(ws + WS_S5TAB); const int gt = F.bid * NTHR + F.tid, gs = F.G * NTHR;
      for (int q = gt; q < 2048; q += gs) { const int g = q >> 6;
        const float dt = expf(A.in[IN_LOGDT][g]); const float lr = A.in[IN_LAMRE][q], li = A.in[IN_LAMIM][q];
        const float mag = expf(lr * dt); float sn, cs; sincosf(li * dt, &sn, &cs);
        const float ar = mag * cs, ai = mag * sn; const float den = lr * lr + li * li;
        const float cr = ((ar - 1.0f) * lr + ai * li) / den, ci = (ai * lr - (ar - 1.0f) * li) / den;
        T[T_AR + q] = ar; T[T_AI + q] = ai;
        float pr = ar, pi = ai;
#pragma unroll
        for (int k = 0; k < 7; ++k) { const float nr = pr * pr - pi * pi, ni = 2.0f * pr * pi; pr = nr; pi = ni; }
        T[T_PR + q] = pr; T[T_PI + q] = pi;
        for (int p = 0; p < 16; ++p) { const float br = A.in[IN_BRE][q * 16 + p], bi = A.in[IN_BIM][q * 16 + p];
            T[T_BBR + q * 16 + p] = cr * br - ci * bi; T[T_BBI + q * 16 + p] = cr * bi + ci * br; } } }
}

typedef pg8::f32x4 pf4;
__device__ __forceinline__ v4u pack8(const pf4 a, const pf4 b) { v4u w; w.x = pk2(a[0], a[1]); w.y = pk2(a[2], a[3]); w.z = pk2(b[0], b[1]); w.w = pk2(b[2], b[3]); return w; }
__device__ __forceinline__ void unpack8(const v4u w, float (&o)[8]) { o[0] = bflo(w.x); o[1] = bfhi(w.x); o[2] = bflo(w.y); o[3] = bfhi(w.y); o[4] = bflo(w.z); o[5] = bfhi(w.z); o[6] = bflo(w.w); o[7] = bfhi(w.w); }

struct Epi1 {
    static constexpr bool PERM = true, AFTER_DRAIN = false;
    bf16* P0; const float* rstd;
    __device__ __forceinline__ void operator()(const pf4 (&acc)[2][2][4][2], const pg8::Unit& u, int wr, int wc, int fr, int fq) const {
        asm volatile("" : "+v"(fr), "+v"(fq));
        const int row0 = u.pm * 256 + wr * 64 + fr, pn = u.pn;
        float rsv[2][4];
#pragma unroll
        for (int ai = 0; ai < 2; ++ai)
#pragma unroll
            for (int m = 0; m < 4; ++m) rsv[ai][m] = rstd[row0 + ai * 128 + m * 16];
#pragma unroll
        for (int ai = 0; ai < 2; ++ai)
#pragma unroll
            for (int m = 0; m < 4; ++m) { const int row = row0 + ai * 128 + m * 16; const float rs = rsv[ai][m]; bf16* rp = P0 + (size_t)row * 2048;
                if (pn < 4) {
                    pf4 a, b;
#pragma unroll
                    for (int j = 0; j < 4; ++j) { a[j] = fgelu(acc[ai][0][m][0][j] * rs) * fsilu(acc[ai][1][m][0][j] * rs); b[j] = fgelu(acc[ai][0][m][1][j] * rs) * fsilu(acc[ai][1][m][1][j] * rs); }
                    *(v4u*)(rp + 128 * pn + 32 * wc + 8 * fq) = pack8(a, b);
                } else {
#pragma unroll
                    for (int bj = 0; bj < 2; ++bj) { pf4 a = acc[ai][bj][m][0] * rs, b = acc[ai][bj][m][1] * rs;
                        if (pn < 6) {
#pragma unroll
                            for (int j = 0; j < 4; ++j) { a[j] = fgelu(a[j]); b[j] = fgelu(b[j]); }
                        } else if (pn >= 8) {
#pragma unroll
                            for (int j = 0; j < 4; ++j) { a[j] = fsilu(a[j]); b[j] = fsilu(b[j]); }
                        }
                        *(v4u*)(rp + 512 + 256 * (pn - 4) + 128 * bj + 32 * wc + 8 * fq) = pack8(a, b); }
                }
                asm volatile("" ::: "memory"); }
    }
};
struct EpiPlain {
    static constexpr bool PERM = true, AFTER_DRAIN = false;
    bf16* O; int ldc;
    __device__ __forceinline__ void operator()(const pf4 (&acc)[2][2][4][2], const pg8::Unit& u, int wr, int wc, int fr, int fq) const {
        asm volatile("" : "+v"(fr), "+v"(fq));
        const int row0 = u.pm * 256 + wr * 64 + fr, col0 = u.pn * 256 + 32 * wc + 8 * fq;
#pragma unroll
        for (int ai = 0; ai < 2; ++ai)
#pragma unroll
            for (int m = 0; m < 4; ++m) { bf16* rp = O + (size_t)(row0 + ai * 128 + m * 16) * ldc + col0;
#pragma unroll
                for (int bj = 0; bj < 2; ++bj) *(v4u*)(rp + 128 * bj) = pack8(acc[ai][bj][m][0], acc[ai][bj][m][1]); }
    }
};
struct EpiGlu {
    static constexpr bool PERM = true, AFTER_DRAIN = false;
    const bf16* YB; const bf16* P0; bf16* MIX;
    __device__ __forceinline__ void operator()(const pf4 (&acc)[2][2][4][2], const pg8::Unit& u, int wr, int wc, int fr, int fq) const {
        asm volatile("" : "+v"(fr), "+v"(fq));
        const int row0 = u.pm * 256 + wr * 64 + fr, col0 = u.pn * 256 + 32 * wc + 8 * fq;
#pragma unroll
        for (int ai = 0; ai < 2; ++ai) {
            v4u yv[4][2], zv[4][2];
#pragma unroll
            for (int m = 0; m < 4; ++m)
#pragma unroll
                for (int bj = 0; bj < 2; ++bj) { const int row = row0 + ai * 128 + m * 16, col = col0 + 128 * bj;
                    yv[m][bj] = *(const v4u*)(YB + (size_t)row * 512 + col); zv[m][bj] = *(const v4u*)(P0 + (size_t)row * 2048 + 1536 + col); }
#pragma unroll
            for (int m = 0; m < 4; ++m) { const int row = row0 + ai * 128 + m * 16;
#pragma unroll
                for (int bj = 0; bj < 2; ++bj) { const int col = col0 + 128 * bj;
                    float y[8], z[8]; unpack8(yv[m][bj], y); unpack8(zv[m][bj], z);
                    pf4 a, b;
#pragma unroll
                    for (int j = 0; j < 4; ++j) { a[j] = y[j] * fsig2(acc[ai][bj][m][0][j] * -1.4426950408889634f) * z[j]; b[j] = y[4 + j] * fsig2(acc[ai][bj][m][1][j] * -1.4426950408889634f) * z[4 + j]; }
                    *(v4u*)(MIX + (size_t)row * DM + 512 + col) = pack8(a, b); } }
            asm volatile("" ::: "memory"); }
    }
};
template <bool XF> struct EpiRes {
    static constexpr bool PERM = true, AFTER_DRAIN = false;
    const float* xp; const float* xs; const bf16* HIN; bf16* HOUT; float* SS;
    __device__ __forceinline__ void operator()(const pf4 (&acc)[2][2][4][2], const pg8::Unit& u, int wr, int wc, int fr, int fq) const {
        asm volatile("" : "+v"(fr), "+v"(fq));
        const int row0 = u.pm * 256 + wr * 64 + fr, col0 = u.pn * 256 + 32 * wc + 8 * fq;
#pragma unroll
        for (int ai = 0; ai < 2; ++ai) {
            f32x4 xv[4][2][2]; v4u hv[4][2];
#pragma unroll
            for (int m = 0; m < 4; ++m)
#pragma unroll
                for (int bj = 0; bj < 2; ++bj) { const int row = row0 + ai * 128 + m * 16, col = col0 + 128 * bj;
                    if (XF) { const float* xr = xrow_ptr(xp, xs, row) + col; xv[m][bj][0] = *(const f32x4*)xr; xv[m][bj][1] = *(const f32x4*)(xr + 4); }
                    else hv[m][bj] = *(const v4u*)(HIN + (size_t)row * DM + col); }
#pragma unroll
            for (int m = 0; m < 4; ++m) { const int row = row0 + ai * 128 + m * 16; float sq = 0.f;
#pragma unroll
                for (int bj = 0; bj < 2; ++bj) { const int col = col0 + 128 * bj; float b[8];
                    if (XF) { const f32x4 x0 = xv[m][bj][0], x1 = xv[m][bj][1]; b[0] = x0.x; b[1] = x0.y; b[2] = x0.z; b[3] = x0.w; b[4] = x1.x; b[5] = x1.y; b[6] = x1.z; b[7] = x1.w; }
                    else unpack8(hv[m][bj], b);
                    pf4 a, c;
#pragma unroll
                    for (int j = 0; j < 4; ++j) { a[j] = b[j] + acc[ai][bj][m][0][j]; c[j] = b[4 + j] + acc[ai][bj][m][1][j]; }
                    *(v4u*)(HOUT + (size_t)row * DM + col) = pack8(a, c);
#pragma unroll
                    for (int j = 0; j < 4; ++j) sq += a[j] * a[j] + c[j] * c[j]; }
                sq += xor16f(sq); sq += xor32f(sq);
                if (fq == 0) SS[(size_t)row * 16 + u.pn * 4 + wc] = sq; }
            asm volatile("" ::: "memory"); }
    }
};
__device__ __forceinline__ float row_rstd16(const float* SS, int row, int fq) {
    const f32x4 v = *(const f32x4*)(SS + (size_t)row * 16 + 4 * fq); float s = (v.x + v.y) + (v.z + v.w);
    s += xor16f(s); s += xor32f(s);
    return 1.0f / sqrtf(s * (1.0f / DM) + EPSN);
}
template <bool FINAL> struct EpiGate {
    static constexpr bool PERM = true, AFTER_DRAIN = false;
    const bf16* HIN; const bf16* PPB; const float* SSin; bf16* HOUT; float* SSout; float* yp; float* ys;
    __device__ __forceinline__ void operator()(const pf4 (&acc)[2][2][4][2], const pg8::Unit& u, int wr, int wc, int fr, int fq) const {
        asm volatile("" : "+v"(fr), "+v"(fq));
        const int row0 = u.pm * 256 + wr * 64 + fr, col0 = u.pn * 256 + 32 * wc + 8 * fq;
#pragma unroll
        for (int ai = 0; ai < 2; ++ai) {
            v4u hv[4][2], pv[4][2]; f32x4 sv[4];
#pragma unroll
            for (int m = 0; m < 4; ++m) { const int row = row0 + ai * 128 + m * 16; sv[m] = *(const f32x4*)(SSin + (size_t)row * 16 + 4 * fq);
#pragma unroll
                for (int bj = 0; bj < 2; ++bj) { const int col = col0 + 128 * bj; hv[m][bj] = *(const v4u*)(HIN + (size_t)row * DM + col); pv[m][bj] = *(const v4u*)(PPB + (size_t)row * DM + col); } }
#pragma unroll
            for (int m = 0; m < 4; ++m) { const int row = row0 + ai * 128 + m * 16;
                float ssum = (sv[m].x + sv[m].y) + (sv[m].z + sv[m].w); ssum += xor16f(ssum); ssum += xor32f(ssum);
                const float rs = (1.0f / sqrtf(ssum * (1.0f / DM) + EPSN)) * -1.4426950408889634f; float sq = 0.f;
#pragma unroll
                for (int bj = 0; bj < 2; ++bj) { const int col = col0 + 128 * bj; float h[8], p[8];
                    unpack8(hv[m][bj], h); unpack8(pv[m][bj], p);
                    pf4 a, c;
#pragma unroll
                    for (int j = 0; j < 4; ++j) { a[j] = h[j] + fsig2(rs * acc[ai][bj][m][0][j]) * p[j]; c[j] = h[4 + j] + fsig2(rs * acc[ai][bj][m][1][j]) * p[4 + j]; }
                    if (FINAL) { float* yr = (row < MP ? yp + (size_t)row * DM : ys + (size_t)(row - MP) * DM) + col; *(f32x4*)yr = (f32x4){a[0], a[1], a[2], a[3]}; *(f32x4*)(yr + 4) = (f32x4){c[0], c[1], c[2], c[3]};
#pragma unroll
                        for (int j = 0; j < 4; ++j) sq += a[j] * a[j] + c[j] * c[j]; }
                    else { *(v4u*)(HOUT + (size_t)row * DM + col) = pack8(a, c);
#pragma unroll
                        for (int j = 0; j < 4; ++j) sq += a[j] * a[j] + c[j] * c[j]; } }
                sq += xor16f(sq); sq += xor32f(sq);
                if (fq == 0) SSout[(size_t)row * 16 + u.pn * 4 + wc] = sq; }
            asm volatile("" ::: "memory"); }
    }
};
struct Epi2 {
    static constexpr bool PERM = true, AFTER_DRAIN = false;
    const float* SSin; bf16* QZ; bf16* QKVD; bf16* ZD; float* AB; float* out;
    __device__ __forceinline__ void operator()(const pf4 (&acc)[2][2][4][2], const pg8::Unit& u, int wr, int wc, int fr, int fq) const {
        asm volatile("" : "+v"(fr), "+v"(fq));
        const int row0 = u.pm * 256 + wr * 64 + fr, pn = u.pn, cl0 = 32 * wc + 8 * fq;
        f32x4 sv[2][4];
#pragma unroll
        for (int ai = 0; ai < 2; ++ai)
#pragma unroll
            for (int m = 0; m < 4; ++m) sv[ai][m] = *(const f32x4*)(SSin + (size_t)(row0 + ai * 128 + m * 16) * 16 + 4 * fq);
#pragma unroll
        for (int ai = 0; ai < 2; ++ai)
#pragma unroll
            for (int m = 0; m < 4; ++m) { const int row = row0 + ai * 128 + m * 16;
                float ssum = (sv[ai][m].x + sv[ai][m].y) + (sv[ai][m].z + sv[ai][m].w); ssum += xor16f(ssum); ssum += xor32f(ssum);
                const float rs = 1.0f / sqrtf(ssum * (1.0f / DM) + EPSN);
                const bool samp = row >= MP; const int rl = samp ? row - MP : row;
                if (pn == 16) { if (wc == 0 && fq == 0) { const pf4 a = acc[ai][0][m][0] * rs, b = acc[ai][0][m][1] * rs; *(f32x4*)(AB + (size_t)row * 8) = (f32x4){a[0], a[1], a[2], a[3]}; *(f32x4*)(AB + (size_t)row * 8 + 4) = (f32x4){b[0], b[1], b[2], b[3]}; } continue; }
#pragma unroll
                for (int bj = 0; bj < 2; ++bj) { const int cl = cl0 + 128 * bj; pf4 a = acc[ai][bj][m][0] * rs, b = acc[ai][bj][m][1] * rs;
                    if (pn < 2) { a = a * (0.125f * 1.4426950408889634f); b = b * (0.125f * 1.4426950408889634f);     *(v4u*)(QZ + (size_t)row * 2048 + 256 * pn + cl) = pack8(a, b); }
                    else if (pn < 6) { const int c = 256 * (pn & 1) + cl; float* o = out + (pn < 4 ? (samp ? O_KCS : O_KCP) : (samp ? O_VCS : O_VCP)) + (size_t)rl * 512 + c;
                        *(f32x4*)o = (f32x4){a[0], a[1], a[2], a[3]}; *(f32x4*)(o + 4) = (f32x4){b[0], b[1], b[2], b[3]};
                        *(v4u*)(QZ + (size_t)row * 2048 + 256 * pn + cl) = pack8(a, b); }
                    else if (pn < 8) {
#pragma unroll
                        for (int j = 0; j < 4; ++j) { a[j] = fsilu(a[j]); b[j] = fsilu(b[j]); }
                        *(v4u*)(QZ + (size_t)row * 2048 + 256 * pn + cl) = pack8(a, b); }
                    else if (pn < 14) { const int c = 256 * (pn - 8) + cl; *(v4u*)(QKVD + (size_t)row * 1536 + c) = pack8(a, b);
                        const int L = samp ? LS : LP, t = rl % L, bb = rl / L;
                        if (t >= L - 3) { float* o = out + (samp ? O_CONVS : O_CONVP) + ((size_t)bb * 3 + (t - (L - 3))) * 1536 + c; *(f32x4*)o = (f32x4){a[0], a[1], a[2], a[3]}; *(f32x4*)(o + 4) = (f32x4){b[0], b[1], b[2], b[3]}; } }
                    else {
#pragma unroll
                        for (int j = 0; j < 4; ++j) { a[j] = fsilu(a[j]); b[j] = fsilu(b[j]); }
                        *(v4u*)(ZD + (size_t)row * 512 + 256 * (pn - 14) + cl) = pack8(a, b); } }
                asm volatile("" ::: "memory"); }
    }
};
__device__ __forceinline__ void chunk128_rows(int ch, int& m0, int& nrows) { if (ch < 512) { m0 = ch * 128; nrows = 128; } else { m0 = MP + (ch - 512) * 64; nrows = 64; } }

constexpr int AB_PITCH = 272, AB_IMG = 128 * AB_PITCH;
typedef short ab_b8 __attribute__((ext_vector_type(8)));
__device__ __forceinline__ void a_branch_unit(ARGREF A, Frame& F, int ch, int gp) {
    const bf16* P0 = (const bf16*)(A.ws + WS_P0BUF); bf16* MIX = (bf16*)(A.ws + WS_MIXIN); const bf16* WB = (const bf16*)(A.ws + WS_AWB);
    int m0, nrows; chunk128_rows(ch, m0, nrows);
    const int lane = F.lane, wave = F.wave, l31 = lane & 31, hh = lane >> 5;
    { float gg[8], gb[8];
#pragma unroll
      for (int j = 0; j < 8; ++j) { gg[j] = A.in[IN_ALNG][8 * lane + j]; gb[j] = A.in[IN_ALNB][8 * lane + j]; }
      for (int r = wave; r < nrows; r += 2 * NWAVES) {
          v4u raw[2];
#pragma unroll
          for (int k = 0; k < 2; ++k) raw[k] = *(const v4u*)(P0 + (size_t)(m0 + r + 8 * k) * 2048 + 512 + 8 * lane);
#pragma unroll
          for (int k = 0; k < 2; ++k) { const int rr = r + 8 * k, m = m0 + rr; float v[8]; unpack8(raw[k], v);
              float s = 0.f;
#pragma unroll
              for (int j = 0; j < 8; ++j) s += v[j];
              const float mean = wave_sum(s) * (1.0f / 512.0f); float q = 0.f;
#pragma unroll
              for (int j = 0; j < 8; ++j) { v[j] -= mean; q += v[j] * v[j]; }
              const float rstd = 1.0f / sqrtf(wave_sum(q) * (1.0f / 512.0f) + EPSN);
#pragma unroll
              for (int j = 0; j < 8; ++j) v[j] = v[j] * rstd * gg[j] + gb[j];
              if ((lane >> 5) == gp) *(LAS v4u*)(F.lds + ((lane >> 4) & 1) * AB_IMG + rr * AB_PITCH + 16 * (lane & 15)) = (v4u){pk2(v[0], v[1]), pk2(v[2], v[3]), pk2(v[4], v[5]), pk2(v[6], v[7])};
              if (gp == 0 && m >= MP) { float* o = A.out + O_AVS + (size_t)(m - MP) * 512 + 8 * lane; *(f32x4*)o = (f32x4){v[0], v[1], v[2], v[3]}; *(f32x4*)(o + 4) = (f32x4){v[4], v[5], v[6], v[7]}; } } } }
    __syncthreads();
    const int gl = wave >> 2, c = wave & 3, g = 2 * gp + gl; const int nt = nrows >> 5;
    f32x16 acc[4];
#pragma unroll
    for (int i = 0; i < 4; ++i)
#pragma unroll
        for (int r = 0; r < 16; ++r) acc[i][r] = 0.f;
    const unsigned trb = (unsigned)(gl * AB_IMG + (8 * hh + ((lane & 15) >> 2)) * AB_PITCH + (32 * c + 16 * ((lane >> 4) & 1) + 4 * (lane & 3)) * 2);
    const bf16* wrow = WB + (size_t)g * 16384 + (size_t)l31 * 128 + 8 * hh;
#pragma unroll
    for (int ks = 0; ks < 8; ++ks) if (ks < 2 * nt) {
        v2u t0, t1;
        asm volatile("ds_read_b64_tr_b16 %0, %1" : "=v"(t0) : "v"(trb + (unsigned)(16 * ks * AB_PITCH)) : "memory");
        asm volatile("ds_read_b64_tr_b16 %0, %1" : "=v"(t1) : "v"(trb + (unsigned)((16 * ks + 4) * AB_PITCH)) : "memory");
        ab_b8 af[4];
#pragma unroll
        for (int i = 0; i < 4; ++i) if (i >= (ks >> 1) && i < nt) af[i] = __builtin_bit_cast(ab_b8, *(const v4u*)(wrow + i * 4096 + 16 * ks));
        asm volatile("s_waitcnt lgkmcnt(0)" : "+v"(t0), "+v"(t1) :: "memory");
        const ab_b8 bf = __builtin_bit_cast(ab_b8, (v4u){t0.x, t0.y, t1.x, t1.y});
#pragma unroll
        for (int i = 0; i < 4; ++i) if (i >= (ks >> 1) && i < nt) acc[i] = __builtin_amdgcn_mfma_f32_32x32x16_bf16(af[i], bf, acc[i], 0, 0, 0);
    }
    const float* bsv = A.in[IN_ABS] + g * 128;
#pragma unroll
    for (int i = 0; i < 4; ++i) if (i < nt) {
#pragma unroll
        for (int r = 0; r < 16; ++r) { const int t = 32 * i + 8 * (r >> 2) + 4 * hh + (r & 3); const size_t m = (size_t)(m0 + t);
            const float uz = bf2f(P0[m * 2048 + 128 * g + 32 * c + l31]);
            MIX[m * DM + 128 * g + 32 * c + l31] = (bf16)f2bf(uz * (acc[i][r] + bsv[t])); } }
    __syncthreads();
}

constexpr int S5_XROW = 80, S5_WLDS = 128 * S5_XROW;
typedef short s5_b8 __attribute__((ext_vector_type(8)));
template <int PASS> __device__ __forceinline__ void s5_unit(ARGREF A, Frame& F, int ch, int g, unsigned xt_off) {
    const bf16* P0 = (const bf16*)(A.ws + WS_P0BUF); const float* T = (const float*)(A.ws + WS_S5TAB);
    int m0, nrows; chunk128_rows(ch, m0, nrows);
    const int lane = fresh_tid(F.wave) & 63, l31 = lane & 31, hh = lane >> 5, l15 = lane & 15, kq = lane >> 4;
    s5_b8 bfr[2][2]; float ar[2], ai[2], cr[2], ci[2], p16r[2], p16i[2];
#pragma unroll
    for (int c = 0; c < 2; ++c) { const int q = g * 64 + 32 * c + l31;
        const float* pr = T + T_BBR + q * 16 + 8 * hh; const float* pi = T + T_BBI + q * 16 + 8 * hh;
        { const f32x4 a = *(const f32x4*)pr, b = *(const f32x4*)(pr + 4); const v4u w = {pk2(a.x, a.y), pk2(a.z, a.w), pk2(b.x, b.y), pk2(b.z, b.w)}; bfr[c][0] = __builtin_bit_cast(s5_b8, w); }
        { const f32x4 a = *(const f32x4*)pi, b = *(const f32x4*)(pi + 4); const v4u w = {pk2(a.x, a.y), pk2(a.z, a.w), pk2(b.x, b.y), pk2(b.z, b.w)}; bfr[c][1] = __builtin_bit_cast(s5_b8, w); }
        ar[c] = T[T_AR + q]; ai[c] = T[T_AI + q];
        { float pr = ar[c], pi = ai[c];
#pragma unroll
          for (int k = 0; k < 4; ++k) { const float nr = pr * pr - pi * pi, ni = 2.0f * pr * pi; pr = nr; pi = ni; }
          p16r[c] = pr; p16i[c] = pi; }
        cr[c] = 0.f; ci[c] = 0.f;
        if (PASS == 2) {
            if (ch < 512) { const float* C = (const float*)(A.ws + WS_S5C) + ((size_t)ch * 2048 + q) * 2; cr[c] = C[0]; ci[c] = C[1]; }
            else { const int b = ch - 512; cr[c] = A.in[IN_SBRE][(size_t)b * 2048 + q]; ci[c] = A.in[IN_SBIM][(size_t)b * 2048 + q]; } } }
    s5_b8 cfr[4]; float dsk = 0.f;
    if (PASS == 2) {
#pragma unroll
        for (int ks = 0; ks < 4; ++ks) { const int k0 = 32 * ks + 8 * kq; const bool im = k0 >= 64;
            const float* cp = (im ? A.in[IN_CIM] : A.in[IN_CRE]) + ((size_t)g * 16 + l15) * 64 + (k0 & 63); const float sg = im ? -1.f : 1.f;
            const f32x4 a = *(const f32x4*)cp, b = *(const f32x4*)(cp + 4);
            const v4u w = {pk2(sg * a.x, sg * a.y), pk2(sg * a.z, sg * a.w), pk2(sg * b.x, sg * b.y), pk2(sg * b.z, sg * b.w)}; cfr[ks] = __builtin_bit_cast(s5_b8, w); }
        dsk = A.in[IN_BD][g * 16 + l15]; }
    const int tperm = 16 * ((l31 >> 2) & 1) + 4 * (l31 >> 3) + (l31 & 3);
    const unsigned trb = xt_off + (unsigned)((8 * kq + (l15 >> 2)) * S5_XROW + 8 * (l15 & 3));
    v4u ufa[4];
#pragma unroll
    for (int tt = 0; tt < 4; ++tt) if (tt < nrows / 32) ufa[tt] = *(const v4u*)(P0 + (size_t)(m0 + 32 * tt + tperm) * 2048 + 1024 + 16 * g + 8 * hh);
    unsigned short uun[8];
    if (PASS == 2) {
#pragma unroll
        for (int q = 0; q < 8; ++q) uun[q] = P0[(size_t)(m0 + 16 * (q >> 2) + 4 * kq + (q & 3)) * 2048 + 1024 + 16 * g + l15]; }
#pragma unroll
    for (int tt = 0; tt < 4; ++tt) if (tt < nrows / 32) {
        const int mt = m0 + 32 * tt;
        const s5_b8 uf = __builtin_bit_cast(s5_b8, ufa[tt]);
        unsigned short uuc[8];
        if (PASS == 2) {
#pragma unroll
            for (int q = 0; q < 8; ++q) uuc[q] = uun[q];
            if (tt + 1 < nrows / 32) {
#pragma unroll
                for (int q = 0; q < 8; ++q) uun[q] = P0[(size_t)(mt + 32 + 16 * (q >> 2) + 4 * kq + (q & 3)) * 2048 + 1024 + 16 * g + l15]; } }
        f32x16 xr[2], xi[2];
#pragma unroll
        for (int c = 0; c < 2; ++c) { f32x16 zz;
#pragma unroll
            for (int r = 0; r < 16; ++r) zz[r] = 0.f;
            xr[c] = __builtin_amdgcn_mfma_f32_32x32x16_bf16(uf, bfr[c][0], zz, 0, 0, 0); xi[c] = __builtin_amdgcn_mfma_f32_32x32x16_bf16(uf, bfr[c][1], zz, 0, 0, 0); }
#pragma unroll
        for (int c = 0; c < 2; ++c) {
            float er = hh == 0 ? cr[c] : 0.f, ei = hh == 0 ? ci[c] : 0.f;
#pragma unroll
            for (int r = 0; r < 16; ++r) { const float nr = ar[c] * er - ai[c] * ei + xr[c][r], ni = ar[c] * ei + ai[c] * er + xi[c][r]; er = nr; ei = ni; }
            const float per_ = xor32f(er), pei_ = xor32f(ei);
            const float c1r = hh ? per_ : er, c1i = hh ? pei_ : ei;
            if (PASS == 1) {
                const float z1r = hh ? er : per_, z1i = hh ? ei : pei_;
                cr[c] = z1r + (p16r[c] * c1r - p16i[c] * c1i); ci[c] = z1i + (p16r[c] * c1i + p16i[c] * c1r);
                continue; }
            float sr = hh == 0 ? cr[c] : c1r, si = hh == 0 ? ci[c] : c1i;
#pragma unroll
            for (int r = 0; r < 16; ++r) { const float nr = ar[c] * sr - ai[c] * si + xr[c][r], ni = ar[c] * si + ai[c] * sr + xi[c][r]; sr = nr; si = ni; xr[c][r] = sr; xi[c][r] = si; }
            { const float psr_ = xor32f(sr), psi_ = xor32f(si); cr[c] = hh ? sr : psr_; ci[c] = hh ? si : psi_; }
        }
        if (PASS == 2) {
#pragma unroll
            for (int c = 0; c < 2; ++c)
#pragma unroll
                for (int part = 0; part < 2; ++part) { const f32x16& x = part ? xi[c] : xr[c];
                    LAS unsigned char* dst = F.lds + xt_off + (64 * part + 32 * c + l31) * S5_XROW + 32 * hh;
                    *(LAS v4u*)dst = (v4u){pk2(x[0], x[1]), pk2(x[2], x[3]), pk2(x[4], x[5]), pk2(x[6], x[7])};
                    *(LAS v4u*)(dst + 16) = (v4u){pk2(x[8], x[9]), pk2(x[10], x[11]), pk2(x[12], x[13]), pk2(x[14], x[15])}; }
            asm volatile("s_waitcnt lgkmcnt(0)" ::: "memory");
            bf16* YB = (bf16*)(A.ws + WS_YB);
#pragma unroll
            for (int t16 = 0; t16 < 2; ++t16) {
                v2u tr[4][2];
#pragma unroll
                for (int ks = 0; ks < 4; ++ks)
#pragma unroll
                    for (int tp = 0; tp < 2; ++tp) asm volatile("ds_read_b64_tr_b16 %0, %1" : "=v"(tr[ks][tp]) : "v"(trb + (unsigned)((32 * ks + 4 * tp) * S5_XROW + 32 * t16)) : "memory");
                asm volatile("s_waitcnt lgkmcnt(0)" : "+v"(tr[0][0]), "+v"(tr[0][1]), "+v"(tr[1][0]), "+v"(tr[1][1]), "+v"(tr[2][0]), "+v"(tr[2][1]), "+v"(tr[3][0]), "+v"(tr[3][1]) :: "memory");
                pf4 acc = {0.f, 0.f, 0.f, 0.f};
#pragma unroll
                for (int ks = 0; ks < 4; ++ks) { const s5_b8 af = __builtin_bit_cast(s5_b8, (v4u){tr[ks][0].x, tr[ks][0].y, tr[ks][1].x, tr[ks][1].y});
                    acc = __builtin_amdgcn_mfma_f32_16x16x32_bf16(af, cfr[ks], acc, 0, 0, 0); }
#pragma unroll
                for (int r = 0; r < 4; ++r) { const int m = mt + 16 * t16 + 4 * kq + r; const float uu = bf2f(uuc[4 * t16 + r]);
                    YB[(size_t)m * 512 + 16 * g + l15] = (bf16)f2bf(fgelu(acc[r] + dsk * uu)); }
            }
        }
    }
    if (hh == 0) {
        int ln_ = (int)__builtin_amdgcn_mbcnt_lo(~0u, 0u); asm volatile("" : "+v"(ln_));
#pragma unroll
        for (int c = 0; c < 2; ++c) { const int q = g * 64 + 32 * c + ln_;
            if (PASS == 1) { float* E = (float*)(A.ws + WS_S5E) + ((size_t)ch * 2048 + q) * 2; E[0] = cr[c]; E[1] = ci[c]; }
            else if (ch >= 512) { const int b = ch - 512; A.out[O_BRES + (size_t)b * 2048 + q] = cr[c]; A.out[O_BIMS + (size_t)b * 2048 + q] = ci[c]; } } }
}
__device__ __forceinline__ void s5_carry(ARGREF A, Frame& F) {
    const float* T = (const float*)(A.ws + WS_S5TAB); const float* E = (const float*)(A.ws + WS_S5E); float* C = (float*)(A.ws + WS_S5C);
    for (int i = F.bid * NTHR + F.tid; i < 8 * 2048; i += F.G * NTHR) { const int b = i >> 11, q = i & 2047;
        const float pr = T[T_PR + q], pi = T[T_PI + q]; float xr = 0.f, xi = 0.f;
        for (int c = 0; c < 64; ++c) { const size_t o = ((size_t)(b * 64 + c) * 2048 + q) * 2; C[o] = xr; C[o + 1] = xi;
            const float er = E[o], ei = E[o + 1]; const float nr = pr * xr - pi * xi + er, ni = pr * xi + pi * xr + ei; xr = nr; xi = ni; }
        A.out[O_BREP + (size_t)b * 2048 + q] = xr; A.out[O_BIMP + (size_t)b * 2048 + q] = xi; }
}
constexpr float SB_CUT = -104.0f * 1.4426950408889634f;
constexpr int AT_VROW = 192, AT_WLDS = 32 * AT_VROW;
typedef short at_b8 __attribute__((ext_vector_type(8)));
__device__ __forceinline__ v4u at_cvt8(const f32x4 a, const f32x4 b) { v4u w; w.x = pk2(a.x, a.y); w.y = pk2(a.z, a.w); w.z = pk2(b.x, b.y); w.w = pk2(b.z, b.w); return w; }
__device__ __forceinline__ void attn_unit(ARGREF A, Frame& F, int unit) {
    const int qt_g = unit >> 3, hd = unit & 7, lane = F.lane, l31 = lane & 31, hh = lane >> 5;
    const int m0 = qt_g * 32;
    const bool samp = m0 >= MP; const int rl0 = samp ? m0 - MP : m0; const int L = samp ? LS : LP; const int b = rl0 / L, t0 = rl0 % L;
    const bf16* QZ = (const bf16*)(A.ws + WS_QZ);
    const unsigned vbase = (unsigned)(F.wave * AT_WLDS);
    at_b8 qf[4];
#pragma unroll
    for (int ks = 0; ks < 4; ++ks) qf[ks] = __builtin_bit_cast(at_b8, *(const v4u*)(QZ + (size_t)(m0 + l31) * 2048 + 64 * hd + 16 * ks + 8 * hh));
    f32x16 O0, O1;
#pragma unroll
    for (int r = 0; r < 16; ++r) { O0[r] = 0.f; O1[r] = 0.f; }
    float carry = 0.f;
    const int brow0 = m0 - t0;
    const int n_new = t0 / 32 + 1, n_tiles = n_new + (samp ? PAST / 32 : 0);
    const float* Kc = A.in[IN_CK] + (size_t)b * PAST * 512 + 64 * hd; const float* Vc = A.in[IN_CV] + (size_t)b * PAST * 512 + 64 * hd;
    const unsigned tr0 = vbase + (unsigned)((4 * hh + ((lane & 15) >> 2)) * AT_VROW + (16 * ((lane >> 4) & 1) + 4 * (lane & 3)) * 2);
    for (int it = 0; it < n_tiles; ++it) {
        const bool from_cache = it >= n_new; const bool diag = it == 0;
        at_b8 kf[4];
        if (!from_cache) {
            const int k0 = brow0 + (n_new - 1 - it) * 32;
#pragma unroll
            for (int ks = 0; ks < 4; ++ks) kf[ks] = __builtin_bit_cast(at_b8, *(const v4u*)(QZ + (size_t)(k0 + l31) * 2048 + 512 + 64 * hd + 16 * ks + 8 * hh));
            const bf16* vp = QZ + (size_t)(k0 + (lane >> 1)) * 2048 + 1024 + 64 * hd + (lane & 1) * 32;
            v4u vv[4];
#pragma unroll
            for (int i = 0; i < 4; ++i) vv[i] = *(const v4u*)(vp + 8 * i);
#pragma unroll
            for (int i = 0; i < 4; ++i) *(LAS v4u*)(F.lds + vbase + (lane >> 1) * AT_VROW + (lane & 1) * 64 + 16 * i) = vv[i];
        } else {
            const int s0 = (n_tiles - 1 - it) * 32;
            const float* kp = Kc + (size_t)(s0 + l31) * 512 + 8 * hh;
#pragma unroll
            for (int ks = 0; ks < 4; ++ks) kf[ks] = __builtin_bit_cast(at_b8, at_cvt8(*(const f32x4*)(kp + 16 * ks), *(const f32x4*)(kp + 16 * ks + 4)));
            const float* vp = Vc + (size_t)(s0 + (lane >> 1)) * 512 + (lane & 1) * 32;
            f32x4 vf[8];
#pragma unroll
            for (int i = 0; i < 8; ++i) vf[i] = *(const f32x4*)(vp + 4 * i);
#pragma unroll
            for (int i = 0; i < 4; ++i) *(LAS v4u*)(F.lds + vbase + (lane >> 1) * AT_VROW + (lane & 1) * 64 + 16 * i) = at_cvt8(vf[2 * i], vf[2 * i + 1]);
        }
        f32x16 z;
#pragma unroll
        for (int r = 0; r < 16; ++r) z[r] = 0.f;
#pragma unroll
        for (int ks = 0; ks < 4; ++ks) z = __builtin_amdgcn_mfma_f32_32x32x16_bf16(kf[ks], qf[ks], z, 0, 0, 0);
        float lk[16];
#pragma unroll
        for (int r = 0; r < 16; ++r) { const float zz = z[r]; float v = -(fmaxf(zz, 0.f) + __builtin_amdgcn_logf(1.0f + __builtin_amdgcn_exp2f(-fabsf(zz))));
            if (diag) { const int key = 8 * (r >> 2) + 4 * hh + (r & 3); if (key >= l31) v = 0.f; }
            lk[r] = v; }
        float R[4], P[4];
#pragma unroll
        for (int g = 0; g < 4; ++g) { R[g] = (lk[4 * g] + lk[4 * g + 1]) + (lk[4 * g + 2] + lk[4 * g + 3]); P[g] = xor32f(R[g]); }
        float sg = carry;
        at_b8 wf[2];
        { unsigned wpk[8];
#pragma unroll
          for (int g = 3; g >= 0; --g) { float aft = sg + (hh == 0 ? P[g] : 0.f); float w4[4];
#pragma unroll
              for (int e = 3; e >= 0; --e) { const int r = 4 * g + e; float w = __builtin_amdgcn_exp2f(lk[r] + z[r] + aft);
                  if (diag) { const int key = 8 * g + 4 * hh + e; if (key >= l31) w = 0.f; }
                  w4[e] = w; aft += lk[r]; }
              wpk[2 * g] = pk2(w4[0], w4[1]); wpk[2 * g + 1] = pk2(w4[2], w4[3]);
              sg += R[g] + P[g]; }
          wf[0] = __builtin_bit_cast(at_b8, (v4u){wpk[0], wpk[1], wpk[2], wpk[3]}); wf[1] = __builtin_bit_cast(at_b8, (v4u){wpk[4], wpk[5], wpk[6], wpk[7]}); }
        carry = sg;
        v2u vr[2][2][2];
#pragma unroll
        for (int s2 = 0; s2 < 2; ++s2)
#pragma unroll
            for (int c = 0; c < 2; ++c)
#pragma unroll
                for (int t = 0; t < 2; ++t) asm volatile("ds_read_b64_tr_b16 %0, %1" : "=v"(vr[s2][c][t]) : "v"(tr0 + (unsigned)((16 * s2 + 8 * t) * AT_VROW + 64 * c)) : "memory");
        asm volatile("s_waitcnt lgkmcnt(0)" : "+v"(vr[0][0][0]), "+v"(vr[0][0][1]), "+v"(vr[0][1][0]), "+v"(vr[0][1][1]), "+v"(vr[1][0][0]), "+v"(vr[1][0][1]), "+v"(vr[1][1][0]), "+v"(vr[1][1][1]) :: "memory");
#pragma unroll
        for (int s2 = 0; s2 < 2; ++s2) {
            const at_b8 vb0 = __builtin_bit_cast(at_b8, (v4u){vr[s2][0][0].x, vr[s2][0][0].y, vr[s2][0][1].x, vr[s2][0][1].y});
            const at_b8 vb1 = __builtin_bit_cast(at_b8, (v4u){vr[s2][1][0].x, vr[s2][1][0].y, vr[s2][1][1].x, vr[s2][1][1].y});
            O0 = __builtin_amdgcn_mfma_f32_32x32x16_bf16(wf[s2], vb0, O0, 0, 0, 0);
            O1 = __builtin_amdgcn_mfma_f32_32x32x16_bf16(wf[s2], vb1, O1, 0, 0, 0); }
        if (__all(carry <= SB_CUT)) break;
    }
    bf16* MIX = (bf16*)(A.ws + WS_MIXIN);
#pragma unroll
    for (int r = 0; r < 16; ++r) { const int m = m0 + 8 * (r >> 2) + 4 * hh + (r & 3);
        const float z0 = bf2f(QZ[(size_t)m * 2048 + 1536 + 64 * hd + l31]), z1 = bf2f(QZ[(size_t)m * 2048 + 1536 + 64 * hd + 32 + l31]);
        MIX[(size_t)m * DM + 64 * hd + l31] = (bf16)f2bf(O0[r] * z0); MIX[(size_t)m * DM + 64 * hd + 32 + l31] = (bf16)f2bf(O1[r] * z1); }
}

__device__ __forceinline__ int chunk64_row0(int cg) { return cg < NCHP ? cg * 64 : MP + (cg - NCHP) * 64; }
constexpr int DP_XQ = 0, DP_XK = 33792, DP_TRI = 0, DP_TB = 17408, DP_AQL = 26624, DP_TF = 35840;
constexpr int DP_QB = 67584, DP_KB = 84992, DP_RT = 102400, DP_GS = 139264;
constexpr int DP_RB = 272, DP_TP = 144;
typedef short dp_b8 __attribute__((ext_vector_type(8)));
__device__ __forceinline__ void dn_prep_unit(ARGREF A, Frame& F, int cg, int h) {
    const bf16* QKVD = (const bf16*)(A.ws + WS_QKVD); const float* AB = (const float*)(A.ws + WS_AB);
    bf16* DW = (bf16*)((unsigned char*)A.out);
    bf16* DU = DW + (size_t)NCH * 4 * 64 * 128; bf16* DQ = DU + (size_t)NCH * 4 * 64 * 128;
    bf16* DK = (bf16*)(A.ws + WS_DK); bf16* DA = (bf16*)(A.ws + WS_DA); float* DEG = (float*)(A.ws + WS_DEG);
    LAS float* qs = (LAS float*)(F.lds + DP_XQ); LAS float* ks = (LAS float*)(F.lds + DP_XK);
    LAS float* tri = (LAS float*)(F.lds + DP_TRI); LAS float* tf = (LAS float*)(F.lds + DP_TF); LAS float* gs = (LAS float*)(F.lds + DP_GS);
    const int tid = F.tid, lane = F.lane, wave = F.wave, l15 = lane & 15, kq = lane >> 4;
    const int m0 = chunk64_row0(cg); const bool samp = cg >= NCHP; const int bs = cg - NCHP; const int cidx = cg * 4 + h;
    const bool first = samp || (cg % 128 == 0);
    const float* cw = A.in[IN_CONVW];
    const bool act = tid < 384; const int cg8 = tid % 48, rseg = tid / 48; const int part = cg8 >> 4, d8 = (cg8 & 15) * 8; const int col = part * 512 + h * 128 + d8;
    v4u xr[11]; f32x4 wa[4], wc[4];
    if (act) {
#pragma unroll
        for (int i = 0; i < 11; ++i) { const int tt = 8 * rseg - 3 + i;
            if (tt >= 0 || !first) xr[i] = *(const v4u*)(QKVD + (size_t)(m0 + tt) * 1536 + col); else xr[i] = (v4u){0u, 0u, 0u, 0u}; }
#pragma unroll
        for (int i = 0; i < 4; ++i) { wa[i] = *(const f32x4*)(cw + i * 1536 + col); wc[i] = *(const f32x4*)(cw + i * 1536 + col + 4); } }
    if (wave == 0) { const int m = m0 + lane; const float a = AB[(size_t)m * 8 + h], bb = AB[(size_t)m * 8 + 4 + h];
        float g = -expf(A.in[IN_ALOG][h]) * fsoftplus(a + A.in[IN_DTB][h]); gs[64 + lane] = fsigmoid(bb);
#pragma unroll
        for (int o = 1; o < 64; o <<= 1) { const float v = __shfl_up(g, o); if (lane >= o) g += v; }
        gs[lane] = g; }
    __syncthreads();
    if (act) {
        float xw[11][8];
#pragma unroll
        for (int i = 0; i < 11; ++i) unpack8(xr[i], xw[i]);
        if (first && samp && rseg == 0) {
#pragma unroll
            for (int i = 0; i < 3; ++i) { const float* sp = A.in[IN_SCONV] + ((size_t)bs * 3 + i) * 1536 + col; const f32x4 a = *(const f32x4*)sp, c = *(const f32x4*)(sp + 4);
                xw[i][0] = a.x; xw[i][1] = a.y; xw[i][2] = a.z; xw[i][3] = a.w; xw[i][4] = c.x; xw[i][5] = c.y; xw[i][6] = c.z; xw[i][7] = c.w; } }
        float w[4][8];
#pragma unroll
        for (int i = 0; i < 4; ++i) { const f32x4 a = wa[i], c = wc[i];
            w[i][0] = a.x; w[i][1] = a.y; w[i][2] = a.z; w[i][3] = a.w; w[i][4] = c.x; w[i][5] = c.y; w[i][6] = c.z; w[i][7] = c.w; }
        float y[8][8];
#pragma unroll
        for (int r = 0; r < 8; ++r)
#pragma unroll
            for (int j = 0; j < 8; ++j) y[r][j] = fsilu(xw[r][j] * w[0][j] + xw[r + 1][j] * w[1][j] + xw[r + 2][j] * w[2][j] + xw[r + 3][j] * w[3][j]);
        if (part < 2) { LAS float* dst = (part == 0 ? qs : ks) + d8;
#pragma unroll
            for (int r = 0; r < 8; ++r) { *(LAS f32x4*)(dst + (8 * rseg + r) * 132) = (f32x4){y[r][0], y[r][1], y[r][2], y[r][3]}; *(LAS f32x4*)(dst + (8 * rseg + r) * 132 + 4) = (f32x4){y[r][4], y[r][5], y[r][6], y[r][7]}; } }
        else { float bt[8];
#pragma unroll
            for (int r = 0; r < 8; ++r) bt[r] = gs[64 + 8 * rseg + r];
#pragma unroll
            for (int j = 0; j < 8; ++j) *(LAS v4u*)(F.lds + DP_RT + (d8 + j) * DP_TP + 16 * rseg) = (v4u){pk2(bt[0] * y[0][j], bt[1] * y[1][j]), pk2(bt[2] * y[2][j], bt[3] * y[3][j]), pk2(bt[4] * y[4][j], bt[5] * y[5][j]), pk2(bt[6] * y[6][j], bt[7] * y[7][j])}; }
    }
    __syncthreads();
    for (int r = wave * 8; r < wave * 8 + 8; ++r) {
        float a0 = qs[r * 132 + lane], a1 = qs[r * 132 + 64 + lane]; float s = wave_sum(a0 * a0 + a1 * a1); float sc = (1.0f / sqrtf(s + EPSN)) * 0.08838834764831845f;
        qs[r * 132 + lane] = a0 * sc; qs[r * 132 + 64 + lane] = a1 * sc;
        a0 = ks[r * 132 + lane]; a1 = ks[r * 132 + 64 + lane]; s = wave_sum(a0 * a0 + a1 * a1); sc = 1.0f / sqrtf(s + EPSN);
        ks[r * 132 + lane] = a0 * sc; ks[r * 132 + 64 + lane] = a1 * sc; }
    __syncthreads();
    { const float Gl = gs[63];
      for (int idx = tid; idx < 64 * 16; idx += NTHR) { const int t = idx >> 4, d8 = (idx & 15) * 8; const float eg = __expf(gs[t]);
          const f32x4 a = *(const LAS f32x4*)(qs + t * 132 + d8), c = *(const LAS f32x4*)(qs + t * 132 + d8 + 4);
          *(LAS v4u*)(F.lds + DP_QB + t * DP_RB + 2 * d8) = (v4u){pk2(a.x, a.y), pk2(a.z, a.w), pk2(c.x, c.y), pk2(c.z, c.w)};
          *(v4u*)(DQ + (size_t)cidx * 8192 + t * 128 + d8) = (v4u){pk2(a.x * eg, a.y * eg), pk2(a.z * eg, a.w * eg), pk2(c.x * eg, c.y * eg), pk2(c.z * eg, c.w * eg)};
          const f32x4 ka = *(const LAS f32x4*)(ks + t * 132 + d8), kc = *(const LAS f32x4*)(ks + t * 132 + d8 + 4);
          *(LAS v4u*)(F.lds + DP_KB + t * DP_RB + 2 * d8) = (v4u){pk2(ka.x, ka.y), pk2(ka.z, ka.w), pk2(kc.x, kc.y), pk2(kc.z, kc.w)}; }
      for (int idx = tid; idx < 128 * 8; idx += NTHR) { const int d = idx & 127, s8 = (idx >> 7) * 8; float v[8], u[8];
#pragma unroll
          for (int j = 0; j < 8; ++j) { const float kv = ks[(s8 + j) * 132 + d], Gs = gs[s8 + j]; v[j] = kv * __expf(Gl - Gs); u[j] = kv * gs[64 + s8 + j] * __expf(Gs); }
          *(v4u*)(DK + (size_t)cidx * 8192 + d * 64 + s8) = (v4u){pk2(v[0], v[1]), pk2(v[2], v[3]), pk2(v[4], v[5]), pk2(v[6], v[7])};
          *(LAS v4u*)(F.lds + DP_RT + (128 + d) * DP_TP + 2 * s8) = (v4u){pk2(u[0], u[1]), pk2(u[2], u[3]), pk2(u[4], u[5]), pk2(u[6], u[7])}; }
      if (tid == 0) DEG[cidx] = __expf(Gl); }
    __syncthreads();
    { const int mat = wave >> 2, mt = wave & 3;
      dp_b8 af[4];
#pragma unroll
      for (int ksp = 0; ksp < 4; ++ksp) af[ksp] = __builtin_bit_cast(dp_b8, *(const LAS v4u*)(F.lds + (mat ? DP_QB : DP_KB) + (16 * mt + l15) * DP_RB + 64 * ksp + 16 * kq));
      pf4 acc[4];
#pragma unroll
      for (int nt = 0; nt < 4; ++nt) { acc[nt] = (pf4){0.f, 0.f, 0.f, 0.f};
#pragma unroll
          for (int ksp = 0; ksp < 4; ++ksp) acc[nt] = __builtin_amdgcn_mfma_f32_16x16x32_bf16(af[ksp], __builtin_bit_cast(dp_b8, *(const LAS v4u*)(F.lds + DP_KB + (16 * nt + l15) * DP_RB + 64 * ksp + 16 * kq)), acc[nt], 0, 0, 0); }
      __syncthreads();
#pragma unroll
      for (int nt = 0; nt < 4; ++nt) { const int s = 16 * nt + l15; const float Gs = gs[s];
#pragma unroll
          for (int r = 0; r < 4; ++r) { const int t = 16 * mt + 4 * kq + r; const float dec = (s <= t) ? __expf(gs[t] - Gs) : 0.f;
              if (mat == 0) tri[t * 68 + s] = (s < t) ? gs[64 + t] * dec * acc[nt][r] : 0.f;
              else *(LAS unsigned short*)(F.lds + DP_AQL + t * DP_TP + 2 * s) = (unsigned short)f2bf(acc[nt][r] * dec); } }
      for (int idx = tid; idx < 64 * 64; idx += NTHR) tf[(idx >> 6) * 68 + (idx & 63)] = ((idx >> 6) == (idx & 63)) ? 1.f : 0.f; }
    __syncthreads();
    if (wave == 0) { const int blk = lane >> 5, cc = lane & 31; LAS float* buf = tf + (32 * blk) * 68 + 32 * blk + cc; const LAS float* tb = tri + (32 * blk) * 68 + 32 * blk;
        for (int I = 0; I < 4; ++I) {
            float acc[8];
#pragma unroll
            for (int i = 0; i < 8; ++i) acc[i] = buf[(8 * I + i) * 68];
            for (int J = 0; J < I; ++J) {
                float xj[8];
#pragma unroll
                for (int j = 0; j < 8; ++j) xj[j] = buf[(8 * J + j) * 68];
#pragma unroll
                for (int i = 0; i < 8; ++i) { const f32x4 t0 = *(const LAS f32x4*)(tb + (8 * I + i) * 68 + 8 * J), t1 = *(const LAS f32x4*)(tb + (8 * I + i) * 68 + 8 * J + 4);
                    acc[i] -= t0.x * xj[0] + t0.y * xj[1] + t0.z * xj[2] + t0.w * xj[3] + t1.x * xj[4] + t1.y * xj[5] + t1.z * xj[6] + t1.w * xj[7]; }
            }
#pragma unroll
            for (int i = 1; i < 8; ++i) { const f32x4 t0 = *(const LAS f32x4*)(tb + (8 * I + i) * 68 + 8 * I), t1 = *(const LAS f32x4*)(tb + (8 * I + i) * 68 + 8 * I + 4);
                const float tv[8] = {t0.x, t0.y, t0.z, t0.w, t1.x, t1.y, t1.z, t1.w};
#pragma unroll
                for (int j = 0; j < i; ++j) acc[i] -= tv[j] * acc[j]; }
#pragma unroll
            for (int i = 0; i < 8; ++i) { buf[(8 * I + i) * 68] = acc[i]; *(LAS unsigned short*)(F.lds + DP_TB + (32 * blk + 8 * I + i) * DP_TP + 2 * (32 * blk + cc)) = (unsigned short)f2bf(acc[i]); }
        }
    } else { for (int idx = tid - 64; idx < 512; idx += NTHR - 64) { const int t = idx >> 3, s8 = (idx & 7) * 8; *(v4u*)(DA + (size_t)cidx * 4096 + t * 64 + s8) = *(const LAS v4u*)(F.lds + DP_AQL + t * DP_TP + 2 * s8); } }
    __syncthreads();
    { const int i = tid >> 4, j2 = (tid & 15) * 2;
      float m0_ = 0.f, m1_ = 0.f;
      for (int k = 0; k < 32; ++k) { const float l = tri[(32 + i) * 68 + k]; m0_ += l * tf[k * 68 + j2]; m1_ += l * tf[k * 68 + j2 + 1]; }
      tf[i * 68 + 32 + j2] = m0_; tf[i * 68 + 32 + j2 + 1] = m1_;
      *(LAS unsigned*)(F.lds + DP_TB + i * DP_TP + 2 * (32 + j2)) = 0u; }
    __syncthreads();
    { const int i = tid >> 4, j2 = (tid & 15) * 2;
      float a0 = 0.f, a1 = 0.f;
      for (int k = 0; k < 32; ++k) { const float t = tf[(32 + i) * 68 + 32 + k]; a0 += t * tf[k * 68 + 32 + j2]; a1 += t * tf[k * 68 + 32 + j2 + 1]; }
      *(LAS unsigned*)(F.lds + DP_TB + (32 + i) * DP_TP + 2 * j2) = pk2(-a0, -a1); }
    __syncthreads();
    { dp_b8 tfr[4][2];
#pragma unroll
      for (int mt = 0; mt < 4; ++mt)
#pragma unroll
          for (int ksp = 0; ksp < 2; ++ksp) tfr[mt][ksp] = __builtin_bit_cast(dp_b8, *(const LAS v4u*)(F.lds + DP_TB + (16 * mt + l15) * DP_TP + 64 * ksp + 16 * kq));
#pragma unroll
      for (int n2 = 0; n2 < 2; ++n2) { const int nt = 2 * wave + n2; const int col = 16 * nt + l15;
          dp_b8 bfr[2];
#pragma unroll
          for (int ksp = 0; ksp < 2; ++ksp) bfr[ksp] = __builtin_bit_cast(dp_b8, *(const LAS v4u*)(F.lds + DP_RT + col * DP_TP + 64 * ksp + 16 * kq));
          bf16* dst = (wave < 4 ? DU : DW) + (size_t)cidx * 8192 + ((16 * nt + 4 * kq) & 127);
#pragma unroll
          for (int mt = 0; mt < 4; ++mt) { pf4 acc = {0.f, 0.f, 0.f, 0.f};
#pragma unroll
              for (int ksp = 0; ksp < 2; ++ksp) acc = __builtin_amdgcn_mfma_f32_16x16x32_bf16(bfr[ksp], tfr[mt][ksp], acc, 0, 0, 0);
              *(uint2*)(dst + (16 * mt + l15) * 128) = make_uint2(pk2(acc[0], acc[1]), pk2(acc[2], acc[3])); } } }
    __syncthreads();
}

constexpr int DS_WROW = 288, DS_KROW = 160;
constexpr int DS_W = 0, DS_Q = 64 * DS_WROW, DS_K = 2 * 64 * DS_WROW, DS_A = DS_K + 128 * DS_KROW, DS_BUF = DS_A + 64 * DS_KROW;
typedef short dsb8 __attribute__((ext_vector_type(8)));
__device__ __forceinline__ dsb8 ds_afrag(const LAS unsigned char* p) { const v2u a = *(const LAS v2u*)p, b = *(const LAS v2u*)(p + 32); const v4u w = {a.x, a.y, b.x, b.y}; return __builtin_bit_cast(dsb8, w); }
__device__ __forceinline__ dsb8 ds_bfrag(const pf4 lo, const pf4 hi) { const v4u w = {pk2(lo[0], lo[1]), pk2(lo[2], lo[3]), pk2(hi[0], hi[1]), pk2(hi[2], hi[3])}; return __builtin_bit_cast(dsb8, w); }
struct DsSrc { const unsigned char* p[8]; };
#define DS_BAR() do { asm volatile("s_waitcnt lgkmcnt(0)" ::: "memory"); __builtin_amdgcn_s_barrier(); asm volatile("" ::: "memory"); } while (0)
__device__ __forceinline__ void dn_seq_unit(ARGREF A, Frame& F, bool samp, int b, int h, int e0) {
    const unsigned char* DW = (const unsigned char*)A.out; const unsigned char* DU = DW + (size_t)NCH * 4 * 64 * 128 * 2; const unsigned char* DQ = DU + (size_t)NCH * 4 * 64 * 128 * 2;
    const unsigned char* DK = (const unsigned char*)(A.ws + WS_DK); const unsigned char* DA = (const unsigned char*)(A.ws + WS_DA); const float* DEG = (const float*)(A.ws + WS_DEG);
    bf16* MIX = (bf16*)(A.ws + WS_MIXIN);
    const int lane = F.lane, wave = F.wave;
    const int nch = samp ? 1 : 128; const int cg0 = samp ? NCHP + b : b * 128;
    __syncthreads();
    if (wave != 0) {
        const int hl = (wave - 1) * 64 + lane;
        unsigned soff[8], doff[8];
        int kind[8];
#pragma unroll
        for (int k = 0; k < 8; ++k) { const int p = hl + 448 * k;
            if (p < 1024) { kind[k] = 0; soff[k] = p * 16; doff[k] = DS_W + (p >> 4) * DS_WROW + (p & 15) * 16; }
            else if (p < 2048) { const int q = p - 1024; kind[k] = 1; soff[k] = q * 16; doff[k] = DS_Q + (q >> 4) * DS_WROW + (q & 15) * 16; }
            else if (p < 3072) { const int q = p - 2048; kind[k] = 2; soff[k] = q * 16; doff[k] = DS_K + (q >> 3) * DS_KROW + (q & 7) * 16; }
            else { const int q = p - 3072; kind[k] = 3; soff[k] = q * 16; doff[k] = DS_A + (q >> 3) * DS_KROW + (q & 7) * 16; } }
        v4u R0[8], R1[8];
#define DS_LOAD(R, c) do { const size_t ci_ = (size_t)((cg0 + (c)) * 4 + h); _Pragma("unroll") for (int k = 0; k < 8; ++k) { \
            const unsigned char* src_ = kind[k] == 0 ? DW + ci_ * 16384 : kind[k] == 1 ? DQ + ci_ * 16384 : kind[k] == 2 ? DK + ci_ * 16384 : DA + ci_ * 8192; \
            R[k] = *(const v4u*)(src_ + soff[k]); } } while (0)
#define DS_PUT(R, bufi) do { _Pragma("unroll") for (int k = 0; k < 8; ++k) *(LAS v4u*)(F.lds + (bufi) * DS_BUF + doff[k]) = R[k]; } while (0)
        DS_LOAD(R0, 0); if (nch > 1) DS_LOAD(R1, 1);
        DS_PUT(R0, 0); if (nch > 2) DS_LOAD(R0, 2);
        DS_BAR();
        for (int c = 0; c < nch; c += 2) {
            if (c + 1 < nch) { DS_PUT(R1, 1); if (c + 3 < nch) DS_LOAD(R1, c + 3); }
            DS_BAR();
            if (c + 1 < nch) {
                if (c + 2 < nch) { DS_PUT(R0, 0); if (c + 4 < nch) DS_LOAD(R0, c + 4); }
                DS_BAR();
            }
        }
#undef DS_LOAD
#undef DS_PUT
    } else {
        const int fr = lane & 15, kq = lane >> 4;
        pf4 S[8];
#pragma unroll
        for (int i = 0; i < 8; ++i)
#pragma unroll
            for (int r = 0; r < 4; ++r) S[i][r] = samp ? A.in[IN_SD][(((size_t)b * 4 + h) * 128 + 16 * i + 4 * kq + r) * 128 + e0 + fr] : 0.f;
        unsigned short un[16], un2[16]; float eg1 = 0.f, eg2 = 0.f;
        { const unsigned short* up = (const unsigned short*)(DU + (size_t)(cg0 * 4 + h) * 16384) + e0 + fr;
#pragma unroll
          for (int q = 0; q < 16; ++q) un[q] = up[(16 * (q >> 2) + 4 * kq + (q & 3)) * 128];
          eg1 = DEG[cg0 * 4 + h];
          if (nch > 1) {
#pragma unroll
              for (int q = 0; q < 16; ++q) un2[q] = up[16384 * 2 + (16 * (q >> 2) + 4 * kq + (q & 3)) * 128];
              eg2 = DEG[cg0 * 4 + h + 4]; } }
        DS_BAR();
        for (int c = 0; c < nch; ++c) {
            const LAS unsigned char* B = F.lds + (c & 1) * DS_BUF;
            const int cidx = (cg0 + c) * 4 + h; const int m0 = chunk64_row0(cg0 + c);
            const float egl = eg1; eg1 = eg2;
            float uc[16];
#pragma unroll
            for (int q = 0; q < 16; ++q) { uc[q] = bf2f(un[q]); un[q] = un2[q]; }
            dsb8 Sb[4];
#pragma unroll
            for (int ks = 0; ks < 4; ++ks) Sb[ks] = ds_bfrag(S[2 * ks], S[2 * ks + 1]);
            pf4 ws[4], oo[4];
#pragma unroll
            for (int mt = 0; mt < 4; ++mt) { ws[mt] = (pf4){0.f, 0.f, 0.f, 0.f}; oo[mt] = (pf4){0.f, 0.f, 0.f, 0.f};
#pragma unroll
                for (int ks = 0; ks < 4; ++ks) {
                    ws[mt] = __builtin_amdgcn_mfma_f32_16x16x32_bf16(ds_afrag(B + DS_W + (16 * mt + fr) * DS_WROW + 64 * ks + 8 * kq), Sb[ks], ws[mt], 0, 0, 0);
                    oo[mt] = __builtin_amdgcn_mfma_f32_16x16x32_bf16(ds_afrag(B + DS_Q + (16 * mt + fr) * DS_WROW + 64 * ks + 8 * kq), Sb[ks], oo[mt], 0, 0, 0); } }
            pf4 dl[4];
#pragma unroll
            for (int mt = 0; mt < 4; ++mt)
#pragma unroll
                for (int r = 0; r < 4; ++r) dl[mt][r] = uc[4 * mt + r] - ws[mt][r];
            dsb8 Db[2];
#pragma unroll
            for (int ks = 0; ks < 2; ++ks) Db[ks] = ds_bfrag(dl[2 * ks], dl[2 * ks + 1]);
#pragma unroll
            for (int i = 0; i < 8; ++i) { S[i] = S[i] * egl;
#pragma unroll
                for (int ks = 0; ks < 2; ++ks) S[i] = __builtin_amdgcn_mfma_f32_16x16x32_bf16(ds_afrag(B + DS_K + (16 * i + fr) * DS_KROW + 64 * ks + 8 * kq), Db[ks], S[i], 0, 0, 0); }
#pragma unroll
            for (int mt = 0; mt < 4; ++mt) {
#pragma unroll
                for (int ks = 0; ks < 2; ++ks) oo[mt] = __builtin_amdgcn_mfma_f32_16x16x32_bf16(ds_afrag(B + DS_A + (16 * mt + fr) * DS_KROW + 64 * ks + 8 * kq), Db[ks], oo[mt], 0, 0, 0);
#pragma unroll
                for (int r = 0; r < 4; ++r) MIX[(size_t)(m0 + 16 * mt + 4 * kq + r) * DM + 512 + h * 128 + e0 + fr] = (bf16)f2bf(oo[mt][r]); }
            asm volatile("" ::: "memory");
            if (c + 2 < nch) { const unsigned short* up = (const unsigned short*)(DU + (size_t)(cidx + 8) * 16384) + e0 + fr;
#pragma unroll
                for (int q = 0; q < 16; ++q) un2[q] = up[(16 * (q >> 2) + 4 * kq + (q & 3)) * 128];
                eg2 = DEG[cidx + 8]; }
            LDS_WAIT();
            DS_BAR();
        }
        float* so = A.out + (samp ? O_SDS : O_SDP) + ((size_t)b * 4 + h) * 128 * 128;
#pragma unroll
        for (int i = 0; i < 8; ++i)
#pragma unroll
            for (int r = 0; r < 4; ++r) so[(16 * i + 4 * kq + r) * 128 + e0 + fr] = S[i][r];
    }
}
__device__ __forceinline__ void dn_out_norm(ARGREF A, Frame& F) {
    const bf16* ZD = (const bf16*)(A.ws + WS_ZD); bf16* MIX = (bf16*)(A.ws + WS_MIXIN);
    const int gw = F.bid * NWAVES + F.wave, NGW = F.G * NWAVES, lane = F.lane;
    float gn[8];
#pragma unroll
    for (int j = 0; j < 8; ++j) gn[j] = A.in[IN_DNORMG][8 * (lane & 15) + j];
    for (int m = 2 * gw; m < MT; m += 2 * NGW) {
        v4u ov[2], zv[2];
#pragma unroll
        for (int k = 0; k < 2; ++k) { ov[k] = *(const v4u*)(MIX + (size_t)(m + k) * DM + 512 + 8 * lane); zv[k] = *(const v4u*)(ZD + (size_t)(m + k) * 512 + 8 * lane); }
#pragma unroll
        for (int k = 0; k < 2; ++k) { float o[8], z[8]; unpack8(ov[k], o); unpack8(zv[k], z);
            float ss = 0.f;
#pragma unroll
            for (int j = 0; j < 8; ++j) ss += o[j] * o[j];
            ss = row16_sum(ss);
            const float rs = 1.0f / sqrtf(ss * (1.0f / 128.0f) + EPSN);
            pf4 a, c;
#pragma unroll
            for (int j = 0; j < 4; ++j) { a[j] = o[j] * rs * gn[j] * z[j]; c[j] = o[4 + j] * rs * gn[4 + j] * z[4 + j]; }
            *(v4u*)(MIX + (size_t)(m + k) * DM + 512 + 8 * lane) = pack8(a, c); } }
}
__device__ __forceinline__ void final_norm(ARGREF A, Frame& F, int row_lo, int row_hi, int gw, int NGW) {
    const float* SS = (const float*)(A.ws + WS_SSB); const float* fg = A.in[IN_FNORMG]; const bf16* H = (const bf16*)(A.ws + WS_HBA);
    const int lane = F.lane;
    float g[2][8];
#pragma unroll
    for (int q = 0; q < 2; ++q)
#pragma unroll
        for (int j = 0; j < 8; ++j) g[q][j] = fg[512 * q + 8 * lane + j];
    for (int m = row_lo + 2 * gw; m < row_hi; m += 2 * NGW) {
        v4u hv[2][2]; float s[2];
#pragma unroll
        for (int k = 0; k < 2; ++k) { const int mm = m + k; s[k] = (lane < 16) ? SS[(size_t)mm * 16 + lane] : 0.f;
#pragma unroll
            for (int q = 0; q < 2; ++q) hv[k][q] = *(const v4u*)(H + (size_t)mm * DM + 512 * q + 8 * lane); }
#pragma unroll
        for (int k = 0; k < 2; ++k) { const int mm = m + k; const float rs = 1.0f / sqrtf(wave_sum(s[k]) * (1.0f / DM) + EPSN);
            float* yr = (mm < MP ? A.out + O_YP + (size_t)mm * DM : A.out + O_YS + (size_t)(mm - MP) * DM) + 8 * lane;
#pragma unroll
            for (int q = 0; q < 2; ++q) { float h[8]; unpack8(hv[k][q], h);
                *(f32x4*)(yr + 512 * q) = (f32x4){h[0] * rs * g[q][0], h[1] * rs * g[q][1], h[2] * rs * g[q][2], h[3] * rs * g[q][3]};
                *(f32x4*)(yr + 512 * q + 4) = (f32x4){h[4] * rs * g[q][4], h[5] * rs * g[q][5], h[6] * rs * g[q][6], h[7] * rs * g[q][7]}; } } }
}
__global__ void __launch_bounds__(NTHR, 2) fwd(Args kernarg_unused) {
    CArgs* ap = (CArgs*)__builtin_amdgcn_kernarg_segment_ptr();
#define A (*ap)
#define RELOAD() asm volatile("" : "+s"(ap))
    extern __shared__ __attribute__((aligned(16))) unsigned char lds_raw[];
    Frame F;
    F.lds = (LAS unsigned char*)lds_raw;
    F.tid = threadIdx.x; F.lane = F.tid & 63; F.wave = __builtin_amdgcn_readfirstlane(F.tid >> 6);
    F.G = gridDim.x; F.bid = blockIdx.x; F.in = nullptr;
    for (int u = F.tid; u < (LDS_BYTES - LDSCTL_OFF) / 4; u += NTHR) ((LAS unsigned*)(F.lds + LDSCTL_OFF))[u] = 0u;
    __syncthreads();
    unsigned char* ws = ap->ws;
    XcdBarrier bar = xcd_barrier_post((unsigned*)ws + CW_BAR, (volatile LAS unsigned*)(F.lds + MISC_OFF) + 8, F.wave == 0);
#define GRID_BAR() do { xcd_barrier(bar, F.wave == 0); RELOAD(); { int t_ = fresh_tid(F.wave); asm volatile("" : "+v"(t_)); F.tid = t_; F.lane = t_ & 63; } } while (0)
    const int gw = F.bid * NWAVES + F.wave, NGW = F.G * NWAVES;
    bf16* HBA = (bf16*)(ws + WS_HBA); bf16* HBB = (bf16*)(ws + WS_HBB); bf16* MIX = (bf16*)(ws + WS_MIXIN); bf16* PPB = (bf16*)(ws + WS_PP);
    bf16* PB = (bf16*)(ws + WS_PB); bf16* P0 = (bf16*)(ws + WS_P0BUF); bf16* YB = (bf16*)(ws + WS_YB);
    float* SSA = (float*)(ws + WS_SSA); float* SSB = (float*)(ws + WS_SSB);

    p0_prologue(A, F);
    GRID_BAR();
    { pg8::Gemm g{HBA, (const bf16*)(ws + WS_W1T), MT, N1, DM, DM, DM}; pg8::StaticOrder S; S.init(MT, N1, F.G, F.bid);
      Epi1 E{P0, (const float*)(ws + WS_RSTD0)};
      pg8::gemm_phase<Epi1, pg8::StaticOrder, true, true>(F.lds, g, S, E, F.wave); }
    const int pp_r1 = (MT / 256) * (N1 / 256) % F.G, pp_n1 = pp_r1 ? (F.G - pp_r1) * 2 : 0;
    const int pp_r5 = (MT / 256) * 2 % F.G, pp_n5 = pp_r5 ? (F.G - pp_r5) : 0;
    if (pp_n1) { pg8::Gemm g{PB, (const bf16*)(ws + WS_WPLE0), MT, DM, 256, 256, 256}; pg8::StaticOrder S; S.init_range(MT, DM, F.G - pp_r1, F.bid >= pp_r1 ? F.bid - pp_r1 : (1 << 28), 0, pp_n1);
      EpiPlain E{PPB, DM};
      pg8::gemm_phase<EpiPlain, pg8::StaticOrder, true, true>(F.lds, g, S, E, F.wave); }
    GRID_BAR();
    for (int u = F.bid; u < 528 * 2; u += F.G) a_branch_unit(A, F, u >> 1, u & 1);
    { int t_ = fresh_tid(F.wave); asm volatile("" : "+v"(t_)); F.tid = t_; F.lane = t_ & 63; }
    for (int wu = gw; wu < 512 * 32; wu += NGW) s5_unit<1>(A, F, wu >> 5, wu & 31, (unsigned)(F.wave * S5_WLDS));
    GRID_BAR();
    s5_carry(A, F);
    GRID_BAR();
    for (int wu = gw; wu < 528 * 32; wu += NGW) s5_unit<2>(A, F, wu >> 5, wu & 31, (unsigned)(F.wave * S5_WLDS));
    GRID_BAR();
    { pg8::Gemm g{YB, (const bf16*)(ws + WS_WGLU), MT, 512, 512, 512, 512}; pg8::StaticOrder S; S.init(MT, 512, F.G, F.bid);
      EpiGlu E{YB, P0, MIX};
      pg8::gemm_phase<EpiGlu, pg8::StaticOrder, true, true>(F.lds, g, S, E, F.wave); }
    if (pp_n5) { pg8::Gemm g{PB, (const bf16*)(ws + WS_WPLE0), MT, DM, 256, 256, 256}; pg8::StaticOrder S; S.init_range(MT, DM, F.G - pp_r5, F.bid >= pp_r5 ? F.bid - pp_r5 : (1 << 28), pp_n1, pp_n1 + pp_n5);
      EpiPlain E{PPB, DM};
      pg8::gemm_phase<EpiPlain, pg8::StaticOrder, true, true>(F.lds, g, S, E, F.wave); }
    GRID_BAR();
    { pg8::Gemm g{MIX, (const bf16*)(ws + WS_WOUT0), MT, DM, DM, DM, DM}; pg8::StaticOrder S; S.init(MT, DM, F.G, F.bid);
      EpiRes<true> E{A.in[IN_XP], A.in[IN_XS], nullptr, HBB, SSA};
      pg8::gemm_phase<EpiRes<true>, pg8::StaticOrder, true, true>(F.lds, g, S, E, F.wave); }
    { pg8::Gemm g{PB, (const bf16*)(ws + WS_WPLE0), MT, DM, 256, 256, 256}; pg8::StaticOrder S; if (F.G >= 64) S.init_range(MT, DM, F.G - 16, F.bid >= 16 ? F.bid - 16 : (1 << 28), pp_n1 + pp_n5, 1 << 28); else S.init_range(MT, DM, F.G, F.bid, pp_n1 + pp_n5, 1 << 28);
      EpiPlain E{PPB, DM};
      pg8::gemm_phase<EpiPlain, pg8::StaticOrder, true, true>(F.lds, g, S, E, F.wave); }
    GRID_BAR();
    if (F.G >= 64 && MP / 256 * 4 % F.G == 0) {
        { pg8::Gemm g{HBB, (const bf16*)(ws + WS_WGATE0), MP, DM, DM, DM, DM}; pg8::StaticOrder S; S.init(MP, DM, F.G, F.bid);
          EpiGate<false> E{HBB, PPB, SSA, HBA, SSB, nullptr, nullptr};
          pg8::gemm_phase<EpiGate<false>, pg8::StaticOrder, true, true>(F.lds, g, S, E, F.wave); }
        GRID_BAR();
        unsigned* sgate = (unsigned*)ws + CW_SGATE;
        if (F.bid < 16) { { pg8::Gemm g{HBB + (size_t)MP * DM, (const bf16*)(ws + WS_WGATE0), MS, DM, DM, DM, DM}; pg8::StaticOrder S; S.init(MS, DM, 16, F.bid);
            EpiGate<false> E{HBB + (size_t)MP * DM, PPB + (size_t)MP * DM, SSA + (size_t)MP * 16, HBA + (size_t)MP * DM, SSB + (size_t)MP * 16, nullptr, nullptr};
            pg8::gemm_phase<EpiGate<false>, pg8::StaticOrder, true, true>(F.lds, g, S, E, F.wave); }
          asm volatile("s_waitcnt vmcnt(0)" ::: "memory"); __syncthreads();
          if (F.wave == 0 && __builtin_amdgcn_mbcnt_lo(~0u, 0u) == 0u) { __builtin_amdgcn_fence(__ATOMIC_RELEASE, "agent"); asm volatile("s_waitcnt vmcnt(0)" ::: "memory"); (void)xb_add(sgate, 1u); } }
        const int n8 = (MT / 256) * (N2 / 256), first8 = (n8 / F.G - 2) * F.G;
        { pg8::Gemm g{HBA, (const bf16*)(ws + WS_W2T), MT, N2, DM, DM, DM}; pg8::FlagOrder S; S.init_range(MT, N2, F.G, F.bid, 0, first8); S.flag = sgate; S.need = 16u; S.pm_wait = MP / 256;
          Epi2 E{SSB, (bf16*)(ws + WS_QZ), (bf16*)(ws + WS_QKVD), (bf16*)(ws + WS_ZD), (float*)(ws + WS_AB), A.out};
          pg8::gemm_phase<Epi2, pg8::FlagOrder, true, true>(F.lds, g, S, E, F.wave); }
        { pg8::Gemm g{HBA, (const bf16*)(ws + WS_W2T), MT, N2, DM, DM, DM}; pg8::FlagOrder S; S.init_range(MT, N2, F.G - 16, F.bid >= 16 ? F.bid - 16 : (1 << 28), first8, 1 << 28); S.flag = sgate; S.need = 16u; S.pm_wait = MP / 256;
          Epi2 E{SSB, (bf16*)(ws + WS_QZ), (bf16*)(ws + WS_QKVD), (bf16*)(ws + WS_ZD), (float*)(ws + WS_AB), A.out};
          pg8::gemm_phase<Epi2, pg8::FlagOrder, true, true>(F.lds, g, S, E, F.wave); }
    } else {
    { pg8::Gemm g{HBB, (const bf16*)(ws + WS_WGATE0), MT, DM, DM, DM, DM}; pg8::StaticOrder S; S.init(MT, DM, F.G, F.bid);
      EpiGate<false> E{HBB, PPB, SSA, HBA, SSB, nullptr, nullptr};
      pg8::gemm_phase<EpiGate<false>, pg8::StaticOrder, true, true>(F.lds, g, S, E, F.wave); }
    GRID_BAR();
    { pg8::Gemm g{HBA, (const bf16*)(ws + WS_W2T), MT, N2, DM, DM, DM}; pg8::StaticOrder S; S.init(MT, N2, F.G, F.bid);
      Epi2 E{SSB, (bf16*)(ws + WS_QZ), (bf16*)(ws + WS_QKVD), (bf16*)(ws + WS_ZD), (float*)(ws + WS_AB), A.out};
      pg8::gemm_phase<Epi2, pg8::StaticOrder, true, true>(F.lds, g, S, E, F.wave); }
    }
    GRID_BAR();
    for (int u = F.bid; u < NCH * 4; u += F.G) dn_prep_unit(A, F, u >> 2, u & 3);
    __syncthreads();
    for (int t = (F.G - 1 - F.bid) * NWAVES + F.wave; t < (MT / 32) * 8; t += NGW) attn_unit(A, F, t);
    GRID_BAR();
    for (int u = F.bid; u < 256 + 512; u += F.G) { const bool samp = u >= 256; const int v = samp ? u - 256 : u; const int xcd = v & 7, j = v >> 3; const int sl = j & 7, bh = (j >> 3) * 8 + xcd;
        dn_seq_unit(A, F, samp, bh >> 2, bh & 3, sl * 16); }
    GRID_BAR();
    dn_out_norm(A, F);
    GRID_BAR();
    { pg8::Gemm g{MIX, (const bf16*)(ws + WS_WOUT1), MT, DM, DM, DM, DM}; pg8::StaticOrder S; S.init(MT, DM, F.G, F.bid);
      EpiRes<false> E{nullptr, nullptr, HBA, HBB, SSA};
      pg8::gemm_phase<EpiRes<false>, pg8::StaticOrder, true, true>(F.lds, g, S, E, F.wave); }
    { pg8::Gemm g{PB + (size_t)MT * 256, (const bf16*)(ws + WS_WPLE1), MT, DM, 256, 256, 256}; pg8::StaticOrder S; if (F.G >= 64) S.init(MT, DM, F.G - 16, F.bid >= 16 ? F.bid - 16 : (1 << 28)); else S.init(MT, DM, F.G, F.bid);
      EpiPlain E{PPB, DM};
      pg8::gemm_phase<EpiPlain, pg8::StaticOrder, true, true>(F.lds, g, S, E, F.wave); }
    GRID_BAR();
    if (F.G >= 64) {
        { pg8::Gemm g{HBB, (const bf16*)(ws + WS_WGATE1), MP, DM, DM, DM, DM}; pg8::StaticOrder S; S.init(MP, DM, F.G, F.bid);
          EpiGate<false> E{HBB, PPB, SSA, HBA, SSB, nullptr, nullptr};
          pg8::gemm_phase<EpiGate<false>, pg8::StaticOrder, true, true>(F.lds, g, S, E, F.wave); }
        GRID_BAR();
        if (F.bid < 16) { pg8::Gemm g{HBB + (size_t)MP * DM, (const bf16*)(ws + WS_WGATE1), MS, DM, DM, DM, DM}; pg8::StaticOrder S; S.init(MS, DM, 16, F.bid);
          EpiGate<false> E{HBB + (size_t)MP * DM, PPB + (size_t)MP * DM, SSA + (size_t)MP * 16, HBA + (size_t)MP * DM, SSB + (size_t)MP * 16, nullptr, nullptr};
          pg8::gemm_phase<EpiGate<false>, pg8::StaticOrder, true, true>(F.lds, g, S, E, F.wave); }
        else final_norm(A, F, 0, MP, (F.bid - 16) * NWAVES + F.wave, (F.G - 16) * NWAVES);
        GRID_BAR();
        final_norm(A, F, MP, MT, gw, NGW);
    } else {
        { pg8::Gemm g{HBB, (const bf16*)(ws + WS_WGATE1), MT, DM, DM, DM, DM}; pg8::StaticOrder S; S.init(MT, DM, F.G, F.bid);
          EpiGate<false> E{HBB, PPB, SSA, HBA, SSB, nullptr, nullptr};
          pg8::gemm_phase<EpiGate<false>, pg8::StaticOrder, true, true>(F.lds, g, S, E, F.wave); }
        GRID_BAR();
        final_norm(A, F, 0, MT, gw, NGW);
    }
#undef A
}

extern "C" void kernel_launch(void* const* d_in, const int* in_sizes, int n_in, void* d_out, int out_size, void* d_ws, size_t ws_size, hipStream_t stream) {
    static int grid = 0;
    if (grid == 0) {
        if (n_in != 36 || (size_t)out_size != O_END || ws_size < WS_END) { fprintf(stderr, "kernel_launch: unexpected sizes n_in %d out %d ws %zu\n", n_in, out_size, ws_size); grid = -1; return; }
        int dev = 0, cus = 0, per_cu = 0;
        if (hipGetDevice(&dev) != hipSuccess || hipDeviceGetAttribute(&cus, hipDeviceAttributeMultiprocessorCount, dev) != hipSuccess) { grid = -1; return; }
        if (hipFuncSetAttribute((const void*)fwd, hipFuncAttributeMaxDynamicSharedMemorySize, LDS_BYTES) != hipSuccess) { grid = -1; return; }
        if (hipOccupancyMaxActiveBlocksPerMultiprocessor(&per_cu, (const void*)fwd, NTHR, LDS_BYTES) != hipSuccess || per_cu < 1) fprintf(stderr, "kernel_launch: occupancy query says %d\n", per_cu);
        (void)hipGetLastError();
        grid = cus > 0 ? cus : 256;
    }
    if (grid < 0) return;
    if (hipMemsetAsync((char*)d_ws + WS_CTL, 0, CTL_ZERO_BYTES, stream) != hipSuccess) return;
    Args a{};
    for (int i = 0; i < 36; ++i) a.in[i] = (const float*)d_in[i];
    a.out = (float*)d_out; a.ws = (unsigned char*)d_ws;
    hipLaunchKernelGGL(fwd, dim3(grid), dim3(NTHR), LDS_BYTES, stream, a);
}
```
